# Optimizing an MI355X kernel written in HIP

```python
import math
import jax, jax.numpy as jnp
from jax import lax
import numpy as np

D_MODEL = 2048
BATCH = 16
SEQ = 2048
DEPTH = 2

HEAD_DIM = D_MODEL // 16
CHUNK = 128
GM_GROUPS = 4
GM_W = GM_GROUPS * HEAD_DIM
ML_HEADS = 6
ML_DK = HEAD_DIM // 2
ML_DV = HEAD_DIM
ML_W = ML_HEADS * ML_DV
ML_CONV = 4
DA_HEADS = 6
DA_DK = HEAD_DIM // 2
DA_DV = HEAD_DIM
DA_W = DA_HEADS * DA_DV
D_MIX = GM_W + ML_W + DA_W
ROPE_THETA = 500000.0
ROPE_DIM = DA_DK // 4
N_GROUPS = 4
EXP_PER_GROUP = 8
N_EXPERTS = N_GROUPS * EXP_PER_GROUP
TOP_K = 2
D_EXPERT = D_MODEL // 4
EPS = 1e-6
IN_SPLIT = (GM_W, GM_W, ML_HEADS * ML_DK, ML_HEADS * ML_DK, ML_W, ML_W, ML_HEADS, ML_HEADS, DA_HEADS * 2 * DA_DK, DA_HEADS * 2 * DA_DK, DA_W)
D_IN = 2 * GM_W + 2 * ML_HEADS * ML_DK + 2 * ML_W + 2 * ML_HEADS + 4 * DA_HEADS * DA_DK + DA_W

kernel_name = 'hybrid_gmlp_mlstm_diffattn_hiermoe'


def _rmsnorm(x, g):
    xf = x.astype(jnp.float32)
    y = xf * lax.rsqrt(jnp.mean(xf * xf, axis=-1, keepdims=True) + EPS)
    return (y * g.astype(jnp.float32)).astype(x.dtype)


def _rope_partial(x, cos, sin):
    half = ROPE_DIM // 2
    x1 = x[..., :half]
    x2 = x[..., half:ROPE_DIM]
    rest = x[..., ROPE_DIM:]
    c = cos[:, None, None, :]
    s = sin[:, None, None, :]
    return jnp.concatenate([x1 * c - x2 * s, x2 * c + x1 * s, rest], axis=-1)


def _causal_conv(x, w, b):
    c = x.shape[-1]
    y = lax.conv_general_dilated(x, w[:, None, :].astype(x.dtype), window_strides=(1,), padding=[(ML_CONV - 1, 0)], dimension_numbers=('NWC', 'WIO', 'NWC'), feature_group_count=c)
    return y + b.astype(x.dtype)


def _gmlp_chunk_mixer(u, v, vnorm_g, ws, bs):
    bsz, s, _ = u.shape
    nc = s // CHUNK
    u = jax.nn.gelu(u, approximate=False)
    v = jax.nn.gelu(v, approximate=False)
    v = _rmsnorm(v.reshape(bsz, s, GM_GROUPS, HEAD_DIM), vnorm_g.reshape(GM_GROUPS, HEAD_DIM))
    v = v.reshape(bsz, nc, CHUNK, GM_GROUPS, HEAD_DIM)
    causal = jnp.tril(jnp.ones((CHUNK, CHUNK), dtype=bool))
    ws_c = jnp.where(causal[None], ws, jnp.zeros((), ws.dtype))
    z = jnp.einsum('gts,bcsgd->bctgd', ws_c, v) + bs.T[None, None, :, :, None]
    return u * z.reshape(bsz, s, GM_W)


def _mlstm_chunk_step(carry, xs):
    c_st, n_st, m_st = carry
    q, k, v, ig, lf = xs
    b = jnp.cumsum(lf, axis=-1)
    causal = jnp.tril(jnp.ones((CHUNK, CHUNK), dtype=bool))
    d = jnp.where(causal, b[..., :, None] - b[..., None, :] + ig[..., None, :], -jnp.inf)
    inter = b + m_st[..., None]
    m_t = jnp.maximum(inter, jnp.max(d, axis=-1))
    w_intra = jnp.exp(d - m_t[..., None])
    w_inter = jnp.exp(inter - m_t)
    s = jnp.einsum('bhtd,bhsd->bhts', q, k) * w_intra
    num = jnp.einsum('bhts,bhsv->bhtv', s, v) + w_inter[..., None] * jnp.einsum('bhtd,bhdv->bhtv', q, c_st)
    den = jnp.sum(s, axis=-1) + w_inter * jnp.einsum('bhtd,bhd->bht', q, n_st)
    h = num / jnp.maximum(jnp.abs(den), jnp.exp(-m_t))[..., None]
    b_end = b[..., -1]
    w_log = b_end[..., None] - b + ig
    m_new = jnp.maximum(b_end + m_st, jnp.max(w_log, axis=-1))
    w_upd = jnp.exp(w_log - m_new[..., None])
    decay = jnp.exp(b_end + m_st - m_new)
    c_new = decay[..., None, None] * c_st + jnp.einsum('bhs,bhsd,bhsv->bhdv', w_upd, k, v)
    n_new = decay[..., None] * n_st + jnp.einsum('bhs,bhsd->bhd', w_upd, k)
    return (c_new, n_new, m_new), h


def _mlstm_mixer(q, k, v, o, ig, fg, conv_w, conv_b, ig_b, fg_b, norm_g):
    bsz, s, _ = q.shape
    nc = s // CHUNK
    f32 = jnp.float32
    qk = jax.nn.silu(_causal_conv(jnp.concatenate([q, k], axis=-1), conv_w, conv_b))
    q, k = jnp.split(qk, 2, axis=-1)

    def heads(t, dh):
        return t.astype(f32).reshape(bsz, nc, CHUNK, ML_HEADS, dh).transpose(1, 0, 3, 2, 4)

    def gates(t):
        return t.reshape(bsz, nc, CHUNK, ML_HEADS).transpose(1, 0, 3, 2)

    qc = heads(q, ML_DK)
    kc = heads(k, ML_DK) * (ML_DK ** -0.5)
    vc = heads(v, ML_DV)
    igc = gates(ig.astype(f32) + ig_b.astype(f32))
    lfc = gates(jax.nn.log_sigmoid(fg.astype(f32) + fg_b.astype(f32)))
    init = (jnp.zeros((bsz, ML_HEADS, ML_DK, ML_DV), f32), jnp.zeros((bsz, ML_HEADS, ML_DK), f32), jnp.zeros((bsz, ML_HEADS), f32))
    _, h = lax.scan(_mlstm_chunk_step, init, (qc, kc, vc, igc, lfc))
    h = h.transpose(1, 0, 3, 2, 4).reshape(bsz, s, ML_HEADS, ML_DV)
    h = _rmsnorm(h, norm_g.reshape(ML_HEADS, ML_DV)).reshape(bsz, s, ML_W)
    return (jax.nn.sigmoid(o.astype(f32)) * h).astype(o.dtype)


def _diff_attention(q, k, v, qn_g, kn_g, lam_p, subln_g, lambda_init, cos, sin):
    bsz, s, _ = q.shape
    nb = s // CHUNK
    q = _rmsnorm(q.reshape(bsz, s, DA_HEADS, 2, DA_DK), qn_g)
    k = _rmsnorm(k.reshape(bsz, s, DA_HEADS, 2, DA_DK), kn_g)
    v = v.reshape(bsz, s, DA_HEADS, DA_DV)
    q = _rope_partial(q, cos, sin) * (DA_DK ** -0.5)
    k = _rope_partial(k, cos, sin)
    lp = lam_p.astype(jnp.float32)
    lam = jnp.exp(jnp.sum(lp[0] * lp[1])) - jnp.exp(jnp.sum(lp[2] * lp[3])) + lambda_init
    qb = q.reshape(bsz, nb, CHUNK, DA_HEADS, 2, DA_DK).transpose(1, 0, 2, 3, 4, 5)
    kpos = jnp.arange(s)

    def block(args):
        qi, i = args
        sc = jnp.einsum('bqhmd,bkhmd->bhmqk', qi, k).astype(jnp.float32)
        qpos = i * CHUNK + jnp.arange(CHUNK)
        mask = kpos[None, :] <= qpos[:, None]
        a = jax.nn.softmax(jnp.where(mask, sc, -jnp.inf), axis=-1)
        a = a[:, :, 0] - lam * a[:, :, 1]
        return jnp.einsum('bhqk,bkhd->bqhd', a.astype(v.dtype), v)

    o = lax.map(block, (qb, jnp.arange(nb)))
    o = o.transpose(1, 0, 2, 3, 4).reshape(bsz, s, DA_HEADS, DA_DV)
    o = _rmsnorm(o, subln_g) * (1.0 - lambda_init)
    return o.reshape(bsz, s, DA_W)


def _hier_moe(x, w_rg, b_rg, w_re, b_re, w_gate, w_up, w_down):
    bsz, s, d = x.shape
    xt = x.reshape(-1, d)
    n = xt.shape[0]
    pg = jax.nn.softmax((xt @ w_rg + b_rg).astype(jnp.float32), axis=-1)
    pg_top, g_idx = lax.top_k(pg, 1)
    le = (xt @ w_re + b_re).astype(jnp.float32).reshape(n, N_GROUPS, EXP_PER_GROUP)
    le_g = le[jnp.arange(n), g_idx[:, 0]]
    pe = jax.nn.softmax(le_g, axis=-1)
    pe_top, e_idx = lax.top_k(pe, TOP_K)
    w = pg_top * pe_top / jnp.sum(pe_top, axis=-1, keepdims=True)
    e_glob = g_idx * EXP_PER_GROUP + e_idx
    combine = jnp.sum(jax.nn.one_hot(e_glob, N_EXPERTS, dtype=jnp.float32) * w[..., None], axis=1)

    def expert_step(acc, params):
        wg, wu, wd, c = params
        hdn = jax.nn.silu(xt @ wg) * (xt @ wu)
        return acc + c[:, None].astype(xt.dtype) * (hdn @ wd), None

    out, _ = lax.scan(expert_step, jnp.zeros_like(xt), (w_gate, w_up, w_down, combine.T))
    return out.reshape(bsz, s, d)


def setup_inputs(seed: int = 0) -> dict:
    key = jax.random.key(seed)
    ks = jax.random.split(key, 24)
    f32 = jnp.float32
    nrm = lambda k, shp, sc: sc * jax.random.normal(k, shp, f32)
    return {
        'x': jax.random.normal(ks[0], (BATCH, SEQ, D_MODEL), f32),
        'norm1_g': 1.0 + nrm(ks[1], (DEPTH, D_MODEL), 0.02),
        'w_in': nrm(ks[2], (DEPTH, D_MODEL, D_IN), D_MODEL ** -0.5),
        'gm_vnorm_g': 1.0 + nrm(ks[3], (DEPTH, GM_W), 0.02),
        'gm_ws': nrm(ks[4], (DEPTH, GM_GROUPS, CHUNK, CHUNK), 0.5 * CHUNK ** -0.5),
        'gm_b': 1.0 + nrm(ks[5], (DEPTH, GM_GROUPS, CHUNK), 0.02),
        'ml_conv_w': nrm(ks[6], (DEPTH, ML_CONV, 2 * ML_HEADS * ML_DK), ML_CONV ** -0.5),
        'ml_conv_b': nrm(ks[7], (DEPTH, 2 * ML_HEADS * ML_DK), 0.02),
        'ml_ig_b': -1.0 + nrm(ks[8], (DEPTH, ML_HEADS), 0.1),
        'ml_fg_b': 3.0 + jnp.linspace(0.0, 3.0, ML_HEADS, dtype=f32)[None, :] + nrm(ks[9], (DEPTH, ML_HEADS), 0.1),
        'ml_norm_g': 1.0 + nrm(ks[10], (DEPTH, ML_W), 0.02),
        'da_qnorm_g': 1.0 + nrm(ks[11], (DEPTH, DA_DK), 0.02),
        'da_knorm_g': 1.0 + nrm(ks[12], (DEPTH, DA_DK), 0.02),
        'da_lambda': nrm(ks[13], (DEPTH, 4, DA_DK), 0.1),
        'da_subln_g': 1.0 + nrm(ks[14], (DEPTH, DA_DV), 0.02),
        'w_out': nrm(ks[15], (DEPTH, D_MIX, D_MODEL), D_MIX ** -0.5),
        'norm2_g': 1.0 + nrm(ks[16], (DEPTH, D_MODEL), 0.02),
        'moe_w_rg': nrm(ks[17], (DEPTH, D_MODEL, N_GROUPS), D_MODEL ** -0.5),
        'moe_b_rg': nrm(ks[18], (DEPTH, N_GROUPS), 0.01),
        'moe_w_re': nrm(ks[19], (DEPTH, D_MODEL, N_EXPERTS), D_MODEL ** -0.5),
        'moe_b_re': nrm(ks[20], (DEPTH, N_EXPERTS), 0.01),
        'moe_w_gate': nrm(ks[21], (DEPTH, N_EXPERTS, D_MODEL, D_EXPERT), D_MODEL ** -0.5),
        'moe_w_up': nrm(ks[22], (DEPTH, N_EXPERTS, D_MODEL, D_EXPERT), D_MODEL ** -0.5),
        'moe_w_down': nrm(ks[23], (DEPTH, N_EXPERTS, D_EXPERT, D_MODEL), D_EXPERT ** -0.5),
    }


def reference(x, norm1_g, w_in, gm_vnorm_g, gm_ws, gm_b, ml_conv_w, ml_conv_b, ml_ig_b, ml_fg_b, ml_norm_g, da_qnorm_g, da_knorm_g, da_lambda, da_subln_g, w_out, norm2_g, moe_w_rg, moe_b_rg, moe_w_re, moe_b_re, moe_w_gate, moe_w_up, moe_w_down):
    s = x.shape[1]
    pos = jnp.arange(s, dtype=jnp.float32)
    inv_freq = ROPE_THETA ** (-jnp.arange(0, ROPE_DIM, 2, dtype=jnp.float32) / ROPE_DIM)
    ang = pos[:, None] * inv_freq[None, :]
    cos = jnp.cos(ang).astype(x.dtype)
    sin = jnp.sin(ang).astype(x.dtype)
    split_at = [int(i) for i in np.cumsum(IN_SPLIT)[:-1]]
    for l in range(DEPTH):
        lambda_init = 0.8 - 0.6 * math.exp(-0.3 * l)
        h = _rmsnorm(x, norm1_g[l])
        proj = jnp.einsum('bsd,de->bse', h, w_in[l])
        gm_u, gm_v, ml_q, ml_k, ml_v, ml_o, ml_i, ml_f, da_q, da_k, da_v = jnp.split(proj, split_at, axis=-1)
        y_gm = _gmlp_chunk_mixer(gm_u, gm_v, gm_vnorm_g[l], gm_ws[l], gm_b[l])
        y_ml = _mlstm_mixer(ml_q, ml_k, ml_v, ml_o, ml_i, ml_f, ml_conv_w[l], ml_conv_b[l], ml_ig_b[l], ml_fg_b[l], ml_norm_g[l])
        y_da = _diff_attention(da_q, da_k, da_v, da_qnorm_g[l], da_knorm_g[l], da_lambda[l], da_subln_g[l], lambda_init, cos, sin)
        mix = jnp.concatenate([y_gm, y_ml, y_da], axis=-1)
        x = x + jnp.einsum('bse,ed->bsd', mix, w_out[l])
        x = x + _hier_moe(_rmsnorm(x, norm2_g[l]), moe_w_rg[l], moe_b_rg[l], moe_w_re[l], moe_b_re[l], moe_w_gate[l], moe_w_up[l], moe_w_down[l])
    return x
```

```cpp
#include <hip/hip_runtime.h>
#include <hip/hip_bf16.h>
#include <cstdio>
#include <cstdint>
#include <cmath>

#ifndef MK_PER_PHASE
#define MK_PER_PHASE 0
#endif

#define GAS __attribute__((address_space(1)))
#define LAS __attribute__((address_space(3)))
typedef unsigned short bf16;
typedef unsigned v4u __attribute__((ext_vector_type(4)));
typedef unsigned v2u __attribute__((ext_vector_type(2)));
typedef float f32x4 __attribute__((ext_vector_type(4)));
typedef float f32x2 __attribute__((ext_vector_type(2)));
typedef float f32x16 __attribute__((ext_vector_type(16)));
typedef short bf16x8 __attribute__((ext_vector_type(8)));
typedef short s16x4 __attribute__((ext_vector_type(4)));
typedef GAS unsigned gu32;
#define RLX_AGENT __ATOMIC_RELAXED, __HIP_MEMORY_SCOPE_AGENT
#define LDS_WAIT() asm volatile("s_waitcnt lgkmcnt(0)" ::: "memory")
#define VM_WAIT() asm volatile("s_waitcnt vmcnt(0)" ::: "memory")

constexpr int NBATCH = 16, SEQ = 2048, DMODEL = 2048, MTOK = NBATCH * SEQ;
constexpr int DIN = 5644, NPROJ = 5632;
constexpr int C_GMU = 0, C_GMV = 512, C_MLQ = 1024, C_MLK = 1408, C_MLV = 1792, C_MLO = 2560, C_DAQ = 3328, C_DAK = 4096, C_DAV = 4864;
constexpr int SRC_GATE = 3328;
constexpr int NEXP = 32, DEXP = 512, SLOT_ROWS = 73728;
constexpr int NLAYER = 2;
constexpr float EPS = 1e-6f;
#ifndef G1_I8
#define G1_I8 1
#endif
#ifndef G1_SPLIT
#define G1_SPLIT 0
#endif
constexpr float SC_WIN = 64.0f;
constexpr float SC_WGU = 64.0f, SC_WD = 32.0f;
constexpr float QSCALE = 0.125f * 1.4426950408889634f;

constexpr size_t MiB = 1u << 20;
constexpr size_t WS_CTL = 0, CTL_ZERO_BYTES = 1 * MiB;
constexpr size_t WS_RWG = 1 * MiB;
constexpr size_t WS_RWR = 1 * MiB + 128 * 1024;
constexpr size_t RW_LSTRIDE = 512 * 1024;
constexpr size_t WS_WIN8 = 127 * MiB;
constexpr size_t WS_ROPE = 126 * MiB;
constexpr size_t WS_WIN = 2 * MiB, WS_WIN1 = 96 * MiB;
constexpr size_t WS_WOUT = 24 * MiB, WS_WOUT1 = 118 * MiB;
constexpr size_t WS_WGU = 32 * MiB;
constexpr size_t WS_WD = 160 * MiB;
constexpr size_t WS_BUFA = 224 * MiB;
constexpr size_t WS_BUFB = 352 * MiB;
constexpr size_t WS_PROJ = 480 * MiB;
constexpr size_t WS_HID = WS_PROJ;
constexpr size_t WS_Y = WS_PROJ + 72 * MiB;
constexpr size_t WS_GATES = 840 * MiB;
constexpr size_t WS_RSTD = 842 * MiB;
constexpr size_t WS_ROUTE = 843 * MiB;
constexpr size_t WS_LIST = 844 * MiB;
constexpr size_t WS_A8 = 848 * MiB;
constexpr size_t WS_XB = 912 * MiB;
constexpr size_t WS_END = 1040 * MiB;
constexpr int CW_TMO = 0, CW_CODE = 1;
constexpr int CW_BAR = 4096;
constexpr int CW_CNT = 16384;
constexpr int CW_CMAX = 32768;
constexpr int CW_Q = 16384 + 256;

constexpr int RING_OFF = 0, RING_BYTES = 131072;
constexpr int LDS_PHASE_BYTES = 151552;
constexpr int MISC_OFF = LDS_PHASE_BYTES;
constexpr int LDS_BYTES = LDS_PHASE_BYTES + 512;

__device__ __forceinline__ int hw_lane() { int l; asm volatile("v_mbcnt_lo_u32_b32 %0, -1, 0\n\tv_mbcnt_hi_u32_b32 %0, -1, %0" : "=v"(l)); return l; }
__device__ __forceinline__ float sx(float v, int m) {
    const int x = __float_as_int(v);
    if (m == 1) return __int_as_float(__builtin_amdgcn_mov_dpp(x, 0xB1, 0xf, 0xf, true));
    if (m == 2) return __int_as_float(__builtin_amdgcn_mov_dpp(x, 0x4E, 0xf, 0xf, true));
    if (m == 4) { int r = __builtin_amdgcn_update_dpp(x, x, 0x104, 0xf, 0x5, false);
                  r = __builtin_amdgcn_update_dpp(r, x, 0x114, 0xf, 0xA, false); return __int_as_float(r); }
    if (m == 8) return __int_as_float(__builtin_amdgcn_mov_dpp(x, 0x128, 0xf, 0xf, true));
    if (m == 16) { auto rr = __builtin_amdgcn_permlane16_swap((unsigned)x, (unsigned)x, false, false); return __uint_as_float(((hw_lane() >> 4) & 1) ? rr[0] : rr[1]); }
    if (m == 32) { auto rr = __builtin_amdgcn_permlane32_swap((unsigned)x, (unsigned)x, false, false); return __uint_as_float((hw_lane() >> 5) ? rr[0] : rr[1]); }
    return __int_as_float(__builtin_amdgcn_ds_bpermute((hw_lane() ^ m) << 2, x));
}
__device__ __forceinline__ float sidx(float v, int i) { return __int_as_float(__builtin_amdgcn_ds_bpermute(i << 2, __float_as_int(v))); }
__device__ __forceinline__ float sup(float v, int d) { return __int_as_float(__builtin_amdgcn_ds_bpermute((hw_lane() - d) << 2, __float_as_int(v))); }
__device__ __forceinline__ unsigned f2bf(float f) { unsigned u = __builtin_bit_cast(unsigned, f); return (u + 0x7fffu + ((u >> 16) & 1u)) >> 16; }
__device__ __forceinline__ float bf2f(unsigned h) { return __builtin_bit_cast(float, h << 16); }
typedef __bf16 bf16x2_t __attribute__((ext_vector_type(2)));
__device__ __forceinline__ unsigned pk2(float lo, float hi) { f32x2 v = {lo, hi}; bf16x2_t b = __builtin_convertvector(v, bf16x2_t); return __builtin_bit_cast(unsigned, b); }
__device__ __forceinline__ unsigned pk_fp8x4(float a, float b, float c, float d) { unsigned w = 0u; w = __builtin_amdgcn_cvt_pk_fp8_f32(a, b, w, false); w = __builtin_amdgcn_cvt_pk_fp8_f32(c, d, w, true); return w; }
__device__ __forceinline__ void unpack_fp8x8(v2u w, float (&x)[8]) { f32x2 a = __builtin_amdgcn_cvt_pk_f32_fp8(w.x, false), b = __builtin_amdgcn_cvt_pk_f32_fp8(w.x, true), c = __builtin_amdgcn_cvt_pk_f32_fp8(w.y, false), d = __builtin_amdgcn_cvt_pk_f32_fp8(w.y, true);
    x[0] = a.x; x[1] = a.y; x[2] = b.x; x[3] = b.y; x[4] = c.x; x[5] = c.y; x[6] = d.x; x[7] = d.y; }
__device__ __forceinline__ float lo_f(unsigned w) { return __builtin_bit_cast(float, w << 16); }
__device__ __forceinline__ float hi_f(unsigned w) { return __builtin_bit_cast(float, w & 0xffff0000u); }
__device__ __forceinline__ float wave_sum(float v) {
#pragma unroll
    for (int o = 1; o < 64; o <<= 1) v += sx(v, o);
    return v;
}
__device__ __forceinline__ float gelu_f(float v) {
    const float av = __builtin_fabsf(v), t = __builtin_amdgcn_rcpf(av * 0.2316418882f + 1.0f);
    float q = t * 0.5307027145f + (-0.7265760135f); q = q * t + 0.7107068705f; q = q * t + (-0.142248368f); q = q * t + 0.127414796f; q = q * t;
    const float e = __builtin_amdgcn_exp2f((v * v) * (-0.72134752044f));
    const float m = v * (q * e);
    return v < 0.f ? m : v - m;
}
__device__ __forceinline__ float silu_f(float v) { return v / (1.0f + __expf(-v)); }
__device__ __forceinline__ float sigmoid_f(float v) { return 1.0f / (1.0f + __expf(-v)); }

#define XB_TMO      128
#define XB_XCNT(j)  (256  + 64 * (j))
#define XB_XSUB(j)  (1280 + 64 * (j))
#define XB_XGEN(j)  (2304 + 64 * (j))
#define XB_TOP      3328
#define XB_TOPGEN   3392
#define XCD_BAR_WORDS 3456
#define XB_SPIN_CAP (1u << 18)

__device__ __forceinline__ unsigned xb_ld(unsigned* p)              { return __hip_atomic_load(p, __ATOMIC_RELAXED, __HIP_MEMORY_SCOPE_AGENT); }
__device__ __forceinline__ unsigned xb_add(unsigned* p, unsigned v) { return __hip_atomic_fetch_add(p, v, __ATOMIC_RELAXED, __HIP_MEMORY_SCOPE_AGENT); }
__device__ __forceinline__ unsigned xb_xcc_id() { return (unsigned)__builtin_amdgcn_s_getreg((3 << 11) | 20) & 0xFu; }
#define XB_SPIN(cond, bar) do { unsigned _sp = 0; while (cond) { __builtin_amdgcn_s_sleep(1); \
    if ((++_sp & 255u) == 0u) { if (xb_ld(&(bar)[XB_TMO])) break; if (_sp > XB_SPIN_CAP) { atomicAdd(&(bar)[XB_TMO], 1u); break; } } } } while (0)

struct XcdBarrier {
    unsigned* bar; unsigned x;
    volatile LAS unsigned* st;
};

__device__ __forceinline__ XcdBarrier xcd_barrier_post(unsigned* bar, volatile LAS unsigned* st, bool t0  ) {
    XcdBarrier b; b.bar = bar; b.x = xb_xcc_id(); b.st = st;
    if (t0) (void)xb_add(&bar[XB_XCNT(b.x)], 1u);
    return b;
}
__device__ __forceinline__ void xcd_barrier_complete(unsigned* bar, unsigned x, unsigned& nloc, unsigned& nx) {
    const unsigned G = gridDim.x * gridDim.y * gridDim.z;
    unsigned sum, cnt, mine, sp = 0u;
    for (;;) {
        sum = 0u; cnt = 0u; mine = 0u;
#pragma unroll 1
        for (unsigned j = 0; j < 16; ++j) { const unsigned c = xb_ld(&bar[XB_XCNT(j)]); sum += c; cnt += (c > 0u) ? 1u : 0u; mine = (j == x) ? c : mine; }
        if (sum == G) break;
        __builtin_amdgcn_s_sleep(1);
        if ((++sp & 255u) == 0u) { if (xb_ld(&bar[XB_TMO])) break; if (sp > XB_SPIN_CAP) { atomicAdd(&bar[XB_TMO], 1u); break; } }
    }
    nloc = mine > 0u ? mine : 1u; nx = cnt > 0u ? cnt : 1u;
}

__device__ __forceinline__ void xcd_barrier(const XcdBarrier& b, bool t0  ) {
    asm volatile("s_waitcnt vmcnt(0)" ::: "memory");
    __syncthreads();
    if (t0) {
        unsigned* bar = b.bar;
        __builtin_amdgcn_s_waitcnt(0);
        unsigned nloc = b.st[0], nx = b.st[1];
        if (nloc == 0u) { xcd_barrier_complete(bar, b.x, nloc, nx); b.st[0] = nloc; b.st[1] = nx; }
        const unsigned old = xb_add(&bar[XB_XSUB(b.x)], 1u);
        const unsigned gen = old / nloc;
        if (old + 1u == (gen + 1u) * nloc) {
            __builtin_amdgcn_fence(__ATOMIC_RELEASE, "agent");
            asm volatile("s_waitcnt vmcnt(0)" ::: "memory");
            const unsigned og = xb_add(&bar[XB_TOP], 1u);
            const unsigned tg = og / nx;
            if (og + 1u == (tg + 1u) * nx) xb_add(&bar[XB_TOPGEN], 1u);
            else XB_SPIN(xb_ld(&bar[XB_TOPGEN]) == tg, bar);
            __builtin_amdgcn_fence(__ATOMIC_ACQUIRE, "agent");
            xb_add(&bar[XB_XGEN(b.x)], 1u);
            asm volatile("s_waitcnt vmcnt(0)" ::: "memory");
        } else {
            XB_SPIN(xb_ld(&bar[XB_XGEN(b.x)]) == gen, bar);
            __builtin_amdgcn_fence(__ATOMIC_ACQUIRE, "agent");
            asm volatile("s_waitcnt vmcnt(0)" ::: "memory");
        }
    }
    __syncthreads();
}

#ifndef PROBE_REP
#define PROBE_REP -1
#endif
__device__ __forceinline__ int gemm_probe_flags();
namespace pg8 {
constexpr int BM = 256, BK = 64, HALF = 128, HTB = HALF * BK * 2  , STAGE_BYTES = 8 * HTB, NXCD = 8, WGM = 4;
__host__ __device__ __forceinline__ int lds_byte(int r, int c) { const int st = (r >> 4) * 2 + (c >> 5), rr = r & 15, cc = c & 31, ob = rr * 64 + cc * 2; return st * 1024 + (ob ^ (((ob >> 9) & 1) << 5)); }
__host__ __device__ __forceinline__ void stage_rc(int b, int& R, int& C) { const int st = b / 1024, sb = b % 1024, swz = sb ^ (((sb >> 9) & 1) << 5); R = (st >> 1) * 16 + swz / 64; C = (st & 1) * 32 + (swz % 64) / 2; }
__host__ __device__ __forceinline__ int perm32(int rho) { const int n = rho >> 4, i = rho & 15; return 8 * (i >> 2) + 4 * n + (i & 3); }

typedef int v4i_t __attribute__((ext_vector_type(4)));
typedef int v8i_t __attribute__((ext_vector_type(8)));
struct Unit { int pm, pn, e; };

__device__ __forceinline__ int g1_tile(int which, int j) {
    if (which == 2) { const int t[22] = {13, 14, 15, 16, 17, 18, 0, 1, 2, 3, 4, 5, 6, 7, 8, 9, 10, 11, 12, 19, 20, 21}; int r = t[0];
#pragma unroll
        for (int k = 1; k < 22; ++k) r = (j == k) ? t[k] : r; return r; }
    if (which == 0) { const int t[14] = {0, 1, 4, 5, 6, 10, 11, 12, 13, 14, 15, 16, 17, 18}; int r = t[0];
#pragma unroll
        for (int k = 1; k < 14; ++k) r = (j == k) ? t[k] : r; return r; }
    const int t[8] = {2, 3, 7, 8, 9, 19, 20, 21}; int r = t[0];
#pragma unroll
    for (int k = 1; k < 8; ++k) r = (j == k) ? t[k] : r; return r;
}
struct DenseOrder {
    const char* A; const char* Bt; int K; int nM, nN, nwg, G, c; int tl;
    __device__ void init(const void* A_, const void* Bt_, int M, int N, int K_, int G_, int c_, int tl_ = -1) { A = (const char*)A_; Bt = (const char*)Bt_; K = K_; nM = M / BM; nN = N / BM; nwg = nM * nN; G = G_; c = c_; tl = tl_; }
    __device__ __forceinline__ bool next(int i, Unit& u) const {
        const long L = (long)i * G + c; if (L >= nwg) return false;
        int wgid = (int)L; { const int q = nwg / NXCD, r = nwg % NXCD, xcd = wgid % NXCD, off = wgid / NXCD; wgid = (xcd < r ? xcd * (q + 1) : r * (q + 1) + (xcd - r) * q) + off; }
        const int nig = WGM * nN, gid = wgid / nig, fm = gid * WGM, gsz = (nM - fm) < WGM ? (nM - fm) : WGM;
        u.pm = fm + ((wgid % nig) % gsz); const int j = (wgid % nig) / gsz; u.pn = tl < 0 ? j : g1_tile(tl, j); u.e = 0; return true;
    }
    __device__ __forceinline__ const char* aptr(const Unit& u) const { return A + (size_t)u.pm * BM * K * 2; }
    __device__ __forceinline__ const char* bptr(const Unit& u) const { return Bt + (size_t)u.pn * BM * K * 2; }
    __device__ __forceinline__ unsigned arow(const Unit&, int r) const { return (unsigned)r; }
};
struct GroupOrder {
    const char* A; const char* Bt; int K; int NJ; size_t bstride_e;
    const LAS int* tp; const int* list; const unsigned* cnt; int G, c; bool gather; size_t arow_bytes;
    __device__ __forceinline__ bool next(int i, Unit& u) const {
        const int T = tp[32]; int rt, jn;
        if (NJ == 8 && (G & 15) == 0) { const int x = c & 7, y = c >> 3, per = G >> 3;
            rt = i * per + (y >> 1) + (per >> 1) * (x >> 2); jn = 2 * (x & 3) + (y & 1); if (rt >= T) return false; }
        else { const int L = i * G + c; if (L >= T * NJ) return false; rt = L / NJ; jn = L - rt * NJ; }
        u.pn = jn; u.pm = rt;
        const int tv = tp[hw_lane() & 31];
        u.e = __builtin_popcount((unsigned)__ballot(tv <= rt)) - 1; return true;
    }
    __device__ __forceinline__ const char* aptr(const Unit& u) const { return gather ? A : A + (size_t)u.pm * BM * arow_bytes; }
    __device__ __forceinline__ const char* bptr(const Unit& u) const { return Bt + (size_t)u.e * bstride_e + (size_t)u.pn * BM * K * 2; }
    __device__ __forceinline__ unsigned arow(const Unit& u, int r) const {
        const int i = (u.pm - tp[u.e]) * BM + r; const unsigned n = cnt[u.e];
        return ((unsigned)i < n) ? (unsigned)list[u.e * 32768 + i] : 0u;
    }
};

__device__ __forceinline__ unsigned cvt_pk_bf16(float lo, float hi) { unsigned r; asm volatile("v_cvt_pk_bf16_f32 %0, %1, %2" : "=v"(r) : "v"(lo), "v"(hi)); return r; }

struct EpiBf16 {
    static constexpr bool PERM = true; static constexpr bool SCL = false;
    bf16* O; int ldc; const float* rs; float cs;
    __device__ __forceinline__ void operator()(const f32x4 (&acc)[2][2][4][2], const Unit& u, int wr, int wc, int fr, int fq) const {
        const int row0 = u.pm * BM + wr * 64 + fr; const int col0 = u.pn * BM + wc * 32 + 8 * fq;
        float sc[2][4];
#pragma unroll
        for (int ai = 0; ai < 2; ++ai)
#pragma unroll
            for (int m = 0; m < 4; ++m) sc[ai][m] = rs ? rs[row0 + ai * HALF + m * 16] * cs : cs;
#pragma unroll
        for (int ai = 0; ai < 2; ++ai)
#pragma unroll
            for (int m = 0; m < 4; ++m) { const int row = row0 + ai * HALF + m * 16; bf16* rowp = O + (size_t)row * ldc + col0;
#pragma unroll
                for (int bj = 0; bj < 2; ++bj) { const f32x4 v0 = acc[ai][bj][m][0] * sc[ai][m], v1 = acc[ai][bj][m][1] * sc[ai][m];
                    v4u w; w.x = cvt_pk_bf16(v0[0], v0[1]); w.y = cvt_pk_bf16(v0[2], v0[3]); w.z = cvt_pk_bf16(v1[0], v1[1]); w.w = cvt_pk_bf16(v1[2], v1[3]);
                    *(v4u*)(rowp + bj * HALF) = w; } }
    }
};
struct EpiFp8 {
    static constexpr bool PERM = true; static constexpr bool SCL = false;
    unsigned char* O; int ldc; float cs;
    __device__ __forceinline__ void operator()(const f32x4 (&acc)[2][2][4][2], const Unit& u, int wr, int wc, int fr, int fq) const {
        const int row0 = u.pm * BM + wr * 64 + fr; const int col0 = u.pn * BM + wc * 32 + 8 * fq;
#pragma unroll
        for (int ai = 0; ai < 2; ++ai)
#pragma unroll
            for (int m = 0; m < 4; ++m) { unsigned char* rowp = O + (size_t)(row0 + ai * HALF + m * 16) * ldc + col0;
#pragma unroll
                for (int bj = 0; bj < 2; ++bj) { const f32x4 v0 = acc[ai][bj][m][0] * cs, v1 = acc[ai][bj][m][1] * cs;
                    v2u w; w.x = pk_fp8x4(v0[0], v0[1], v0[2], v0[3]); w.y = pk_fp8x4(v1[0], v1[1], v1[2], v1[3]);
                    *(v2u*)(rowp + bj * HALF) = w; } }
    }
};
struct EpiResF32 {
    static constexpr bool PERM = false; static constexpr bool SCL = false;
    const float* res; float* out; int ldc;
    __device__ __forceinline__ void operator()(const f32x4 (&acc)[2][2][4][2], const Unit& u, int wr, int wc, int fr, int fq) const {
        const int row0 = u.pm * BM + wr * 64 + fr; const int col0 = u.pn * BM + wc * 32 + 4 * fq;
#pragma unroll
        for (int ai = 0; ai < 2; ++ai) {
            f32x4 r[4][2][2];
#pragma unroll
            for (int m = 0; m < 4; ++m)
#pragma unroll
                for (int bj = 0; bj < 2; ++bj)
#pragma unroll
                    for (int n = 0; n < 2; ++n) r[m][bj][n] = *(const f32x4*)(res + (size_t)(row0 + ai * HALF + m * 16) * ldc + col0 + bj * HALF + n * 16);
#pragma unroll
            for (int m = 0; m < 4; ++m)
#pragma unroll
                for (int bj = 0; bj < 2; ++bj)
#pragma unroll
                    for (int n = 0; n < 2; ++n) *(f32x4*)(out + (size_t)(row0 + ai * HALF + m * 16) * ldc + col0 + bj * HALF + n * 16) = r[m][bj][n] + acc[ai][bj][m][n];
        }
    }
};
__device__ constexpr float ROPE_FH[8] = {0.15911865234375f, 0.03086090087890625f, 0.0059833526611328125f, 0.0011606216430664062f, 0.000225067138671875f, 4.3645501136779785e-05f, 8.4638595581054688e-06f, 1.6409903764724731e-06f};
__device__ constexpr float ROPE_FL[8] = {3.62907485e-05f, 2.86252589e-06f, 1.83305156e-06f, 4.19981738e-08f, 1.19403678e-08f, 2.45165599e-09f, 4.7125015e-10f, 4.35886327e-10f};
template <bool I8> struct EpiProjQK {
    static constexpr bool PERM = true; static constexpr bool SCL = I8;
    bf16* O; int ldc; const float* rs; float cs; const float* qg; const float* kg; const f32x4* rope; LAS float* xch; const unsigned* cmax; LAS float* scl;
    __device__ __forceinline__ void stage(const Unit& u, int wid) const {
        if (wid < 2) { const unsigned* src = (wid == 0 ? (const unsigned*)rs + u.pm * BM : cmax + u.pn * BM) + hw_lane() * 4;
            __builtin_amdgcn_global_load_lds(src, (LAS unsigned*)(scl + u.e * 512 + wid * 256), 16, 0, 0); }
    }
    __device__ __forceinline__ void operator()(const f32x4 (&acc)[2][2][4][2], const Unit& u, int wr, int wc, int fr_, int fq_) const {
        const int ln_ = hw_lane(), fr = ln_ & 15, fq = ln_ >> 4; (void)fr_; (void)fq_;
        const int row0 = u.pm * BM + wr * 64 + fr; const int col0 = u.pn * BM + wc * 32 + 8 * fq;
        float sc[2][4];
#pragma unroll
        for (int ai = 0; ai < 2; ++ai)
#pragma unroll
            for (int m = 0; m < 4; ++m) sc[ai][m] = (I8 ? scl[u.e * 512 + wr * 64 + fr + ai * HALF + m * 16] : rs[row0 + ai * HALF + m * 16]) * cs;
        float wsc[2][8];
#pragma unroll
        for (int bj = 0; bj < 2; ++bj)
#pragma unroll
            for (int e = 0; e < 8; ++e) wsc[bj][e] = I8 ? scl[u.e * 512 + 256 + wc * 32 + 8 * fq + bj * HALF + e] * (1.0f / 127.0f) : 1.0f;
#define EPQ_V(ai_, bj_, m_, n_, k_) ((I8 ? (float)__float_as_int(acc[ai_][bj_][m_][n_][k_]) : acc[ai_][bj_][m_][n_][k_]) * wsc[bj_][(n_) * 4 + (k_)])
        const bool isqk = u.pn >= 13 && u.pn < 19;
        if (!isqk) {
#pragma unroll
            for (int ai = 0; ai < 2; ++ai)
#pragma unroll
                for (int m = 0; m < 4; ++m) { bf16* rowp = O + (size_t)(row0 + ai * HALF + m * 16) * ldc + col0;
#pragma unroll
                    for (int bj = 0; bj < 2; ++bj) { const float r_ = sc[ai][m];
                        v4u w; w.x = cvt_pk_bf16(EPQ_V(ai, bj, m, 0, 0) * r_, EPQ_V(ai, bj, m, 0, 1) * r_); w.y = cvt_pk_bf16(EPQ_V(ai, bj, m, 0, 2) * r_, EPQ_V(ai, bj, m, 0, 3) * r_);
                        w.z = cvt_pk_bf16(EPQ_V(ai, bj, m, 1, 0) * r_, EPQ_V(ai, bj, m, 1, 1) * r_); w.w = cvt_pk_bf16(EPQ_V(ai, bj, m, 1, 2) * r_, EPQ_V(ai, bj, m, 1, 3) * r_);
                        *(v4u*)(rowp + bj * HALF) = w; } }
            return;
        }
        const int half = wc & 1, mp = wc >> 1;
#pragma unroll
        for (int ai = 0; ai < 2; ++ai)
#pragma unroll
            for (int m = 0; m < 4; ++m)
#pragma unroll
                for (int bj = 0; bj < 2; ++bj) { const float r_ = sc[ai][m]; float s = 0.f;
#pragma unroll
                    for (int n = 0; n < 2; ++n)
#pragma unroll
                        for (int k = 0; k < 4; ++k) { const float v_ = EPQ_V(ai, bj, m, n, k) * r_; s += v_ * v_; }
                    { auto r16 = __builtin_amdgcn_permlane16_swap(__float_as_uint(s), __float_as_uint(s), false, false); s = __uint_as_float(r16[0]) + __uint_as_float(r16[1]);
                      auto r32 = __builtin_amdgcn_permlane32_swap(__float_as_uint(s), __float_as_uint(s), false, false); s = __uint_as_float(r32[0]) + __uint_as_float(r32[1]); }
                    if (fq == 0) xch[((ai * HALF + wr * 64 + m * 16 + fr) * 4 + bj * 2 + mp) * 2 + half] = s; }
        const bool isq = u.pn < 16; const float* gsrc = (isq ? qg : kg) + 32 * half + 8 * fq; float g[2][8];
#pragma unroll
        for (int bj = 0; bj < 2; ++bj)
#pragma unroll
            for (int e = 0; e < 8; ++e) g[bj][e] = gsrc[e] * (isq ? QSCALE : 1.0f) * wsc[bj][e];
        asm volatile("s_waitcnt lgkmcnt(0)" ::: "memory"); __builtin_amdgcn_s_barrier(); asm volatile("" ::: "memory");
#define EPQ_R(ai_, bj_, m_, n_, k_) (I8 ? (float)__float_as_int(acc[ai_][bj_][m_][n_][k_]) : acc[ai_][bj_][m_][n_][k_])
#pragma unroll
        for (int ai = 0; ai < 2; ++ai)
#pragma unroll
            for (int m = 0; m < 4; ++m) { const int rt = ai * HALF + wr * 64 + m * 16 + fr, row = u.pm * BM + rt; bf16* rowp = O + (size_t)row * ldc + col0;
                float rcs[8], rsn[8];
                if (half == 0) { const float pos = (float)(row & (SEQ - 1));
#pragma unroll
                    for (int e = 0; e < 8; ++e) { const float t = __builtin_amdgcn_fractf(pos * ROPE_FH[e]) + pos * ROPE_FL[e]; rcs[e] = __builtin_amdgcn_cosf(t); rsn[e] = __builtin_amdgcn_sinf(t); } }
#pragma unroll
                for (int bj = 0; bj < 2; ++bj) { const LAS float* xp = xch + (rt * 4 + bj * 2 + mp) * 2;
                    const float rn = sc[ai][m] / sqrtf((xp[0] + xp[1]) * (1.0f / 64.0f) + EPS);
                    float x[8];
#pragma unroll
                    for (int n = 0; n < 2; ++n)
#pragma unroll
                        for (int k = 0; k < 4; ++k) x[n * 4 + k] = EPQ_R(ai, bj, m, n, k) * rn * g[bj][n * 4 + k];
                    if (half == 0) {
                        float px[8];
#pragma unroll
                        for (int e = 0; e < 8; ++e) { auto rr = __builtin_amdgcn_permlane16_swap(__float_as_uint(x[e]), __float_as_uint(x[e]), false, false); px[e] = __uint_as_float((fq & 1) ? rr[0] : rr[1]); }
                        if (fq < 2) {
#pragma unroll
                            for (int e = 0; e < 8; ++e) x[e] = (fq == 0) ? x[e] * rcs[e] - px[e] * rsn[e] : x[e] * rcs[e] + px[e] * rsn[e];
                        }
                    }
                    v4u w; w.x = cvt_pk_bf16(x[0], x[1]); w.y = cvt_pk_bf16(x[2], x[3]); w.z = cvt_pk_bf16(x[4], x[5]); w.w = cvt_pk_bf16(x[6], x[7]);
                    *(v4u*)(rowp + bj * HALF) = w; }
                __builtin_amdgcn_sched_barrier(0); }
#undef EPQ_V
#undef EPQ_R
    }
};
template <bool RESF32> struct EpiResBf16 {
    static constexpr bool PERM = true; static constexpr bool SCL = false;
    const void* res; bf16* out; int ldc;
    __device__ __forceinline__ void operator()(const f32x4 (&acc)[2][2][4][2], const Unit& u, int wr, int wc, int fr, int fq) const {
        const int row0 = u.pm * BM + wr * 64 + fr; const int col0 = u.pn * BM + wc * 32 + 8 * fq;
#pragma unroll
        for (int ai = 0; ai < 2; ++ai) {
            f32x4 r[4][2][2];
#pragma unroll
            for (int m = 0; m < 4; ++m)
#pragma unroll
                for (int bj = 0; bj < 2; ++bj) { const size_t o = (size_t)(row0 + ai * HALF + m * 16) * ldc + col0 + bj * HALF;
                    if constexpr (RESF32) { r[m][bj][0] = *(const f32x4*)((const float*)res + o); r[m][bj][1] = *(const f32x4*)((const float*)res + o + 4); }
                    else { const v4u w = *(const v4u*)((const bf16*)res + o); r[m][bj][0] = (f32x4){lo_f(w.x), hi_f(w.x), lo_f(w.y), hi_f(w.y)}; r[m][bj][1] = (f32x4){lo_f(w.z), hi_f(w.z), lo_f(w.w), hi_f(w.w)}; } }
#pragma unroll
            for (int m = 0; m < 4; ++m)
#pragma unroll
                for (int bj = 0; bj < 2; ++bj) { const f32x4 v0 = r[m][bj][0] + acc[ai][bj][m][0], v1 = r[m][bj][1] + acc[ai][bj][m][1];
                    v4u w; w.x = cvt_pk_bf16(v0[0], v0[1]); w.y = cvt_pk_bf16(v0[2], v0[3]); w.z = cvt_pk_bf16(v1[0], v1[1]); w.w = cvt_pk_bf16(v1[2], v1[3]);
                    *(v4u*)(out + (size_t)(row0 + ai * HALF + m * 16) * ldc + col0 + bj * HALF) = w; }
        }
    }
};
struct EpiSwiglu {
    static constexpr bool PERM = true; static constexpr bool SCL = false;
    unsigned char* O; const float* rstd; GroupOrder S; float cs;
    __device__ __forceinline__ void operator()(const f32x4 (&acc)[2][2][4][2], const Unit& u, int wr, int wc, int fr, int fq) const {
        const int col0 = u.pn * HALF + wc * 32 + 8 * fq;
        unsigned tok[2][4]; float sc[2][4];
#pragma unroll
        for (int ai = 0; ai < 2; ++ai)
#pragma unroll
            for (int m = 0; m < 4; ++m) tok[ai][m] = S.arow(u, ai * HALF + wr * 64 + m * 16 + fr);
#pragma unroll
        for (int ai = 0; ai < 2; ++ai)
#pragma unroll
            for (int m = 0; m < 4; ++m) sc[ai][m] = rstd[tok[ai][m]] * cs;
#pragma unroll
        for (int ai = 0; ai < 2; ++ai)
#pragma unroll
            for (int m = 0; m < 4; ++m) { const int rt = ai * HALF + wr * 64 + m * 16 + fr;
                unsigned char* rowp = O + (size_t)(u.pm * BM + rt) * DEXP + col0; float h[8];
#pragma unroll
                for (int n = 0; n < 2; ++n)
#pragma unroll
                    for (int k = 0; k < 4; ++k) { const float g = acc[ai][0][m][n][k] * sc[ai][m], up = acc[ai][1][m][n][k] * sc[ai][m]; h[n * 4 + k] = g / (1.0f + __expf(-g)) * up; }
                v2u w; w.x = pk_fp8x4(h[0], h[1], h[2], h[3]); w.y = pk_fp8x4(h[4], h[5], h[6], h[7]);
                *(v2u*)rowp = w; }
    }
};

template <class Epi, class Sched, bool ALIGN_EPI, bool GATHER, int FP8 = 0  >
__device__ __forceinline__ void gemm_phase(LAS unsigned char* lds, const Sched& S, const Epi& E, int wave) {
    int tid_ = wave * 64 + hw_lane(); asm volatile("" : "+v"(tid_));
    const int tid = tid_, wid = __builtin_amdgcn_readfirstlane(tid >> 6), lane = tid & 63, wr = wid >> 2, wc = wid & 3, fr = lane & 15, fq = lane >> 4;
    const int K = S.K, nt = K / BK;
    unsigned voffA[2], voffB[2]; int RA[2], CA[2];
#pragma unroll
    for (int i = 0; i < 2; ++i) { int R, C; stage_rc(tid * 16 + i * 8192, R, C); const int Rb = Epi::PERM ? ((R & ~31) + perm32(R & 31)) : R;
        RA[i] = R; CA[i] = C; voffA[i] = (unsigned)(R * K + C) * 2u; voffB[i] = (unsigned)(Rb * K + C) * 2u; }
    const size_t kstep = (size_t)(BK * 2);
    const size_t hstep = (size_t)HALF * K * 2;
    const unsigned ldsw = (unsigned)wid * 1024u;
    const int aoff = lds_byte(wr * 64 + fr, fq * 8), boff = lds_byte(wc * 32 + fr, fq * 8);
#define PG8_SA(b, h) (((b) * 2 + (h)) * HTB)
#define PG8_SB(b, h) ((4 + (b) * 2 + (h)) * HTB)
#define PG8_STAGE(bufoff, gbase, voff) do { _Pragma("unroll") for (int _i = 0; _i < 2; ++_i) \
        __builtin_amdgcn_global_load_lds((const unsigned*)((const char*)(gbase) + (voff)[_i]), (LAS unsigned*)(lds + (bufoff) + ldsw + _i * 8192), 16, 0, 0); } while (0)
#define PG8_STAGE_A(bufoff, h, gk, go) do { if constexpr (GATHER) { PG8_STAGE(bufoff, gk, (go)[h]); } else { PG8_STAGE(bufoff, (gk) + (h) * hstep, voffA); } } while (0)
#define PG8_LD8(off) __builtin_shufflevector(*(const LAS v4i_t*)(lds + (off)), *(const LAS v4i_t*)(lds + (off) + 1024), 0, 1, 2, 3, 4, 5, 6, 7)
#define PG8_LDA(dst, b, h) do { _Pragma("unroll") for (int m = 0; m < 4; ++m) dst[m] = PG8_LD8(PG8_SA(b, h) + aoff + m * 2048); } while (0)
#define PG8_LDB(dst, b, h) do { _Pragma("unroll") for (int n = 0; n < 2; ++n) dst[n] = PG8_LD8(PG8_SB(b, h) + boff + n * 2048); } while (0)
#define PG8_HALF(x, k) __builtin_bit_cast(bf16x8, __builtin_shufflevector(x, x, 4 * (k), 4 * (k) + 1, 4 * (k) + 2, 4 * (k) + 3))
#define PG8_MMA(ai, bj, At, Bt) do { if (PROBE_REP >= 0 && (pflags & 32768)) break; __builtin_amdgcn_s_setprio(1); _Pragma("unroll") for (int m = 0; m < 4; ++m) _Pragma("unroll") for (int n = 0; n < 2; ++n) { \
        if constexpr (FP8 == 2) { acc[ai][bj][m][n] = __builtin_bit_cast(f32x4, __builtin_amdgcn_mfma_i32_16x16x64_i8(__builtin_bit_cast(v4i_t, PG8_HALF(Bt[n], 0)), __builtin_bit_cast(v4i_t, PG8_HALF(At[m], 0)), __builtin_bit_cast(v4i_t, acc[ai][bj][m][n]), 0, 0, 0)); \
               acc[ai][bj][m][n] = __builtin_bit_cast(f32x4, __builtin_amdgcn_mfma_i32_16x16x64_i8(__builtin_bit_cast(v4i_t, PG8_HALF(Bt[n], 1)), __builtin_bit_cast(v4i_t, PG8_HALF(At[m], 1)), __builtin_bit_cast(v4i_t, acc[ai][bj][m][n]), 0, 0, 0)); } \
        else if constexpr (FP8 == 1) { asm volatile("v_mfma_scale_f32_16x16x128_f8f6f4 %0, %1, %2, %0, %3, %3 op_sel_hi:[0,0,0]" : "+v"(acc[ai][bj][m][n]) : "v"(Bt[n]), "v"(At[m]), "v"(sc1)); } \
        else { acc[ai][bj][m][n] = __builtin_amdgcn_mfma_f32_16x16x32_bf16(PG8_HALF(Bt[n], 0), PG8_HALF(At[m], 0), acc[ai][bj][m][n], 0, 0, 0); \
               acc[ai][bj][m][n] = __builtin_amdgcn_mfma_f32_16x16x32_bf16(PG8_HALF(Bt[n], 1), PG8_HALF(At[m], 1), acc[ai][bj][m][n], 0, 0, 0); } } \
        __builtin_amdgcn_s_setprio(0); } while (0)
#define PG8_WAIT_V(n) asm volatile("s_waitcnt vmcnt(" #n ")" ::: "memory")
#define PG8_WAIT_L(n) asm volatile("s_waitcnt lgkmcnt(" #n ")" ::: "memory")
#define PG8_BAR __builtin_amdgcn_s_barrier()
#define PG8_SCHED __builtin_amdgcn_sched_barrier(0)
#define PG8_GOFF(dst, u) do { if constexpr (GATHER) { _Pragma("unroll") for (int _h = 0; _h < 2; ++_h) _Pragma("unroll") for (int _i = 0; _i < 2; ++_i) \
        dst[_h][_i] = S.arow(u, _h * HALF + RA[_i]) * (unsigned)(K * 2) + (unsigned)(CA[_i] * 2); } } while (0)
    Unit cur, nxt; int ui = 0;
    if (!S.next(0, cur)) return;
    float zz = 0.f; asm volatile("" : "+v"(zz));
    f32x4 acc[2][2][4][2];
#pragma unroll
    for (int a = 0; a < 2; ++a)
#pragma unroll
        for (int b = 0; b < 2; ++b)
#pragma unroll
            for (int m = 0; m < 4; ++m)
#pragma unroll
                for (int n = 0; n < 2; ++n) acc[a][b][m][n] = (f32x4){zz, zz, zz, zz};
    int sc1 = 0x7f7f7f7f; asm volatile("" : "+v"(sc1));
    v8i_t At[4], B0[2], B1[2];
    unsigned cgo[2][2] = {{0u, 0u}, {0u, 0u}}, ngo[2][2] = {{0u, 0u}, {0u, 0u}};
    const int pflags = PROBE_REP >= 0 ? gemm_probe_flags() : 0;
    const char* cA = (pflags & 512) ? S.A : S.aptr(cur); const char* cB = (pflags & 512) ? S.Bt : S.bptr(cur);
    PG8_GOFF(cgo, cur);
    if constexpr (Epi::SCL) { cur.e = 0; E.stage(cur, wid); }
    PG8_STAGE(PG8_SB(0, 0), cB, voffB); PG8_STAGE(PG8_SB(0, 1), cB + hstep, voffB); PG8_STAGE_A(PG8_SA(0, 0), 0, cA, cgo); PG8_STAGE_A(PG8_SA(0, 1), 1, cA, cgo);
    if (wr == 1) PG8_BAR;
    PG8_WAIT_V(2); PG8_BAR;
    PG8_STAGE(PG8_SB(1, 0), cB + kstep, voffB); PG8_STAGE_A(PG8_SA(1, 0), 0, cA + kstep, cgo); PG8_STAGE(PG8_SB(1, 1), cB + hstep + kstep, voffB);
    PG8_WAIT_V(6); PG8_BAR;
    for (;;) {
        const bool has_next = S.next(ui + 1, nxt);
        if constexpr (Epi::SCL) nxt.e = (ui + 1) & 1;
        const char* nA = (has_next && !(pflags & 512)) ? S.aptr(nxt) : cA; const char* nB = (has_next && !(pflags & 512)) ? S.bptr(nxt) : cB;
        if constexpr (GATHER) { if (has_next) { PG8_GOFF(ngo, nxt); } else { ngo[0][0] = cgo[0][0]; ngo[0][1] = cgo[0][1]; ngo[1][0] = cgo[1][0]; ngo[1][1] = cgo[1][1]; } }
        for (int t = 0; t < nt; t += 2) {
            const bool last = (t == nt - 2);
            const char* a1 = cA + (size_t)(t + 1) * kstep;
            const char* a2 = last ? nA : cA + (size_t)(t + 2) * kstep; const char* b2 = last ? nB : cB + (size_t)(t + 2) * kstep;
            const char* a3 = a2 + kstep; const char* b3 = b2 + kstep;
            unsigned sgo[2][2];
            if constexpr (GATHER) { sgo[0][0] = last ? ngo[0][0] : cgo[0][0]; sgo[0][1] = last ? ngo[0][1] : cgo[0][1]; sgo[1][0] = last ? ngo[1][0] : cgo[1][0]; sgo[1][1] = last ? ngo[1][1] : cgo[1][1]; }
            PG8_LDB(B0, 0, 0); PG8_LDB(B1, 0, 1); PG8_SCHED; PG8_LDA(At, 0, 0); PG8_STAGE_A(PG8_SA(1, 1), 1, a1, cgo);
            PG8_WAIT_V(8); PG8_WAIT_L(0); PG8_BAR; PG8_MMA(0, 0, At, B0); PG8_MMA(0, 1, At, B1); PG8_BAR; PG8_SCHED;
            PG8_LDA(At, 0, 1); PG8_STAGE(PG8_SB(0, 0), b2, voffB); PG8_STAGE(PG8_SB(0, 1), b2 + hstep, voffB); PG8_STAGE_A(PG8_SA(0, 0), 0, a2, sgo);
            PG8_WAIT_V(8); PG8_WAIT_L(0); PG8_BAR; PG8_MMA(1, 0, At, B0); PG8_MMA(1, 1, At, B1); PG8_BAR; PG8_SCHED;
            PG8_LDB(B0, 1, 0); PG8_LDB(B1, 1, 1); PG8_SCHED; PG8_LDA(At, 1, 0); PG8_STAGE_A(PG8_SA(0, 1), 1, a2, sgo);
            PG8_WAIT_V(8); PG8_WAIT_L(0); PG8_BAR; PG8_MMA(0, 0, At, B0); PG8_MMA(0, 1, At, B1); PG8_BAR; PG8_SCHED;
            PG8_LDA(At, 1, 1); PG8_STAGE(PG8_SB(1, 0), b3, voffB); PG8_STAGE(PG8_SB(1, 1), b3 + hstep, voffB); PG8_STAGE_A(PG8_SA(1, 0), 0, a3, sgo);
            PG8_WAIT_V(8); PG8_WAIT_L(0); PG8_BAR; PG8_MMA(1, 0, At, B0); PG8_MMA(1, 1, At, B1); PG8_BAR; PG8_SCHED;
        }
        if constexpr (ALIGN_EPI) { if (wr == 0) PG8_BAR; }
        if constexpr (FP8 == 1) asm volatile("s_nop 15\n\ts_nop 15" ::: "memory");
        if (!(pflags & 256)) E(acc, cur, wr, wc, fr, fq);
        if (!has_next) break;
#pragma unroll
        for (int a = 0; a < 2; ++a)
#pragma unroll
            for (int b = 0; b < 2; ++b)
#pragma unroll
                for (int m = 0; m < 4; ++m)
#pragma unroll
                    for (int n = 0; n < 2; ++n) acc[a][b][m][n] = (f32x4){zz, zz, zz, zz};
        cur = nxt; cA = nA; cB = nB; ++ui;
        if constexpr (Epi::SCL) E.stage(cur, wid);
        if constexpr (GATHER) { cgo[0][0] = ngo[0][0]; cgo[0][1] = ngo[0][1]; cgo[1][0] = ngo[1][0]; cgo[1][1] = ngo[1][1]; }
        if constexpr (ALIGN_EPI) { if (wr == 1) PG8_BAR; }
    }
    PG8_WAIT_V(0);
    if constexpr (!ALIGN_EPI) { if (wr == 0) PG8_BAR; }
    PG8_BAR;
#undef PG8_SA
#undef PG8_SB
#undef PG8_STAGE
#undef PG8_STAGE_A
#undef PG8_LDA
#undef PG8_LDB
#undef PG8_MMA
#undef PG8_HALF
#undef PG8_LD8
#undef PG8_WAIT_V
#undef PG8_WAIT_L
#undef PG8_BAR
#undef PG8_SCHED
#undef PG8_GOFF
}
}

#include <hip/hip_bf16.h>
namespace attn_body {
using bf16=__hip_bfloat16;
using bf16x8=__attribute__((ext_vector_type(8)))short;
using s16x4=__attribute__((ext_vector_type(4)))short;
using f32x16=__attribute__((ext_vector_type(16)))float;
using u32x4=__attribute__((ext_vector_type(4)))unsigned;
constexpr int D=64,DM=5632;
constexpr int NW=8,QBLK=32,QB=QBLK*NW,KVBLK=64;
constexpr int ATTN_UNIT_ROWS=QB;
__device__ __forceinline__ int crow(int r,int hi){return (r&3)+8*(r>>2)+4*hi;}
#define SBAR() __builtin_amdgcn_sched_barrier(0)
__device__ __forceinline__ void cmask(f32x16&p0,f32x16&p1,int jb,int qrel,int hi){
  const float NEG=-INFINITY; int kb=64*jb+4*hi;
  #pragma unroll
  for(int r=0;r<16;++r){int kv=kb+(r&3)+8*(r>>2); if(kv>qrel)p0[r]=NEG; if(kv+32>qrel)p1[r]=NEG;}
}

constexpr int NSLOT=3, SLOTB=8192;
constexpr int LDS_K=0, LDS_V=NSLOT*SLOTB, LDS_WS=2*NSLOT*SLOTB, LDS_HOLD=LDS_WS+NW*64*4, LDS_BYTES=LDS_HOLD+NW*8192;
constexpr float C2=0.125f*1.4426950408889634f;
__device__ __forceinline__ void glds16(const void*gsrc,unsigned lds_dst){unsigned keep;
  asm volatile("s_mov_b32 %0, m0\n\ts_mov_b32 m0, %2\n\ts_nop 0\n\tglobal_load_lds_dwordx4 %1, off\n\ts_mov_b32 m0, %0":"=&s"(keep):"v"(gsrc),"s"(lds_dst):"memory");}
__device__ __forceinline__ float max3f(float a,float b,float c){float r;asm("v_max3_f32 %0, %1, %2, %3":"=v"(r):"v"(a),"v"(b),"v"(c));return r;}
__device__ __forceinline__ float max2f(float a,float b){float r;asm("v_max_f32_e32 %0, %1, %2":"=v"(r):"v"(a),"v"(b));return r;}
__device__ __forceinline__ float fadd_s(float a,float b){float r;asm("v_add_f32_e32 %0, %1, %2":"=v"(r):"v"(a),"v"(b));return r;}
__device__ __forceinline__ float fsub_s(float a,float b){float r;asm("v_sub_f32_e32 %0, %1, %2":"=v"(r):"v"(a),"v"(b));return r;}
typedef float f32x2_t __attribute__((ext_vector_type(2))); typedef __bf16 bf16x2_t __attribute__((ext_vector_type(2)));
__device__ __forceinline__ unsigned cvtpk_s(float lo,float hi){f32x2_t v={lo,hi};bf16x2_t b=__builtin_convertvector(v,bf16x2_t);return __builtin_bit_cast(unsigned,b);}
#define WAIT_BAR(N) asm volatile("s_waitcnt vmcnt(" #N ") lgkmcnt(0)\n\ts_barrier":::"memory")

__device__ __forceinline__ void qkt(f32x16&p0,f32x16&p1,const char*Kslot,const bf16x8*qr,const f32x16&negm,int r32,int hi){
  const char*kb=Kslot+hi*1024+r32*16;
  #pragma unroll
  for(int d0=0;d0<4;++d0){
    const bf16x8 b0=*reinterpret_cast<const bf16x8*>(kb+d0*2048);
    const bf16x8 b1=*reinterpret_cast<const bf16x8*>(kb+d0*2048+512);
    if(d0==0){p0=__builtin_amdgcn_mfma_f32_32x32x16_bf16(b0,qr[0],negm,0,0,0);p1=__builtin_amdgcn_mfma_f32_32x32x16_bf16(b1,qr[0],negm,0,0,0);}
    else{p0=__builtin_amdgcn_mfma_f32_32x32x16_bf16(b0,qr[d0],p0,0,0,0);p1=__builtin_amdgcn_mfma_f32_32x32x16_bf16(b1,qr[d0],p1,0,0,0);}}
}
typedef __attribute__((address_space(3))) const char* lds_cptr;
typedef short v4i16_t __attribute__((ext_vector_type(4)));
__device__ __forceinline__ void kload8(bf16x8*kf,lds_cptr kp){
  kf[0]=*(const __attribute__((address_space(3))) bf16x8*)(kp);      kf[1]=*(const __attribute__((address_space(3))) bf16x8*)(kp+512);
  kf[2]=*(const __attribute__((address_space(3))) bf16x8*)(kp+2048); kf[3]=*(const __attribute__((address_space(3))) bf16x8*)(kp+2560);
  kf[4]=*(const __attribute__((address_space(3))) bf16x8*)(kp+4096); kf[5]=*(const __attribute__((address_space(3))) bf16x8*)(kp+4608);
  kf[6]=*(const __attribute__((address_space(3))) bf16x8*)(kp+6144); kf[7]=*(const __attribute__((address_space(3))) bf16x8*)(kp+6656);
}
__device__ __forceinline__ void kload2(bf16x8*kf,lds_cptr kp,int j){ kf[2*j]=*(const __attribute__((address_space(3))) bf16x8*)(kp+j*2048); kf[2*j+1]=*(const __attribute__((address_space(3))) bf16x8*)(kp+j*2048+512); }
__device__ __forceinline__ s16x4 vtr(lds_cptr p){ return __builtin_bit_cast(s16x4,__builtin_amdgcn_ds_read_tr16_b64_v4i16((__attribute__((address_space(3))) v4i16_t*)p)); }
__device__ __forceinline__ float rowmax(const f32x16&p0,const f32x16&p1){
  float a=max3f(p0[0],p0[1],p1[0]),b=max3f(p0[2],p0[3],p1[1]);a=max3f(a,p1[2],p1[3]);
  #pragma unroll
  for(int r=4;r<16;r+=4){a=max3f(a,p0[r],p0[r+1]);b=max3f(b,p0[r+2],p0[r+3]);a=max3f(a,p1[r],p1[r+1]);b=max3f(b,p1[r+2],p1[r+3]);}
  const float m=max2f(a,b);
  auto rr=__builtin_amdgcn_permlane32_swap(__float_as_uint(m),__float_as_uint(m),false,false);
  return max2f(__uint_as_float(rr[0]),__uint_as_float(rr[1]));
}
__device__ __forceinline__ void pv(f32x16*o,int vb,bf16x8 pa0,bf16x8 pa1,bf16x8 pa2,bf16x8 pa3){
  #pragma unroll
  for(int d0=0;d0<2;++d0){s16x4 lo[4],hi[4];
    #pragma unroll
    for(int ks=0;ks<4;++ks){
      asm volatile("ds_read_b64_tr_b16 %0,%1 offset:%c2":"=&v"(lo[ks]):"v"(vb),"i"(d0*4096+ks*1024):"memory");
      asm volatile("ds_read_b64_tr_b16 %0,%1 offset:%c2":"=&v"(hi[ks]):"v"(vb),"i"(d0*4096+ks*1024+512):"memory");}
    asm volatile("s_waitcnt lgkmcnt(0)":::"memory");SBAR();
    #define PK(k) (bf16x8){lo[k][0],lo[k][1],lo[k][2],lo[k][3],hi[k][0],hi[k][1],hi[k][2],hi[k][3]}
    o[d0]=__builtin_amdgcn_mfma_f32_32x32x16_bf16(pa0,PK(0),o[d0],0,0,0);
    o[d0]=__builtin_amdgcn_mfma_f32_32x32x16_bf16(pa1,PK(1),o[d0],0,0,0);
    o[d0]=__builtin_amdgcn_mfma_f32_32x32x16_bf16(pa2,PK(2),o[d0],0,0,0);
    o[d0]=__builtin_amdgcn_mfma_f32_32x32x16_bf16(pa3,PK(3),o[d0],0,0,0);
    #undef PK
  }
}

#ifndef ATTN_STORE16
#define ATTN_STORE16(p,v) (*(u32x4*)(p)=(v))
#endif
template<int THRL> __device__ __forceinline__ void attn_run(const bf16*Qw0,const bf16*__restrict__ Kh,const bf16*__restrict__ Vh,int q0,char*shm,int mode,int fcol,float lam,int wave){
  int tid_=wave*64+hw_lane(); asm volatile("":"+v"(tid_));
  const int tid=tid_,lane=tid&63,r32=lane&31,hi=lane>>5; const int wid=__builtin_amdgcn_readfirstlane(tid>>6);

  const bf16*Qw=Qw0+(long)(wid*QBLK)*DM;

  const unsigned lds0=(unsigned)(uintptr_t)shm;
  float*wsf=(float*)(shm+LDS_WS)+wid*64;
  const bf16*ksrc=Kh+(long)lane*DM+wid*8;
  const bf16*vsrc=Vh+(long)(16*(wid&3)+(lane>>2))*DM+(wid>>2)*32+(lane&3)*8;
  const unsigned kdst=lds0+LDS_K+wid*1024, vdst=lds0+LDS_V+wid*1024;
  #define DMA_K(t,slot) glds16(ksrc+(long)(t)*KVBLK*DM,(unsigned)__builtin_amdgcn_readfirstlane(kdst+(slot)))
  #define DMA_V(t,slot) glds16(vsrc+(long)(t)*KVBLK*DM,(unsigned)__builtin_amdgcn_readfirstlane(vdst+(slot)))
  const int vb0=(int)(lds0+LDS_V)+((lane>>4)&1)*32+(lane&3)*8+(4*hi+((lane&15)>>2))*64;
  const char*Kbase=shm+LDS_K; bf16x8 kf[8];
  const lds_cptr shm3=(lds_cptr)shm; const lds_cptr kp0=shm3+LDS_K+hi*1024+r32*16; const lds_cptr vp0=shm3+LDS_V+((lane>>4)&1)*32+(lane&3)*8+(4*hi+((lane&15)>>2))*64;
  const int NT=(q0+QB)/KVBLK;
  DMA_K(0,0);DMA_V(0,0);DMA_K(1,SLOTB);
  bf16x8 qr[4];
  #pragma unroll
  for(int d0=0;d0<4;++d0)qr[d0]=*reinterpret_cast<const bf16x8*>(&Qw[(long)r32*DM+d0*16+hi*8]);
  float mhat=0.f,l_reg=0.f;f32x16 o[2];o[0]=f32x16{};o[1]=f32x16{};const f32x16 negm=f32x16{};
  const int qrel=wid*QBLK+r32;
  #define CMASK(P0,P1,t) do{int jb_=(t)-(NT-4); if(jb_>=0)cmask(P0,P1,jb_,qrel,hi);}while(0)
  bool resc=false;
  #define START(P0,P1) do{ const float rm=rowmax(P0,P1); resc=false; \
    { const float dl=rm; mhat=fadd_s(mhat,dl); \
      _Pragma("unroll") for(int r=0;r<16;++r){P0[r]=fsub_s(P0[r],dl);P1[r]=fsub_s(P1[r],dl);} \
      } \
    _Pragma("unroll") for(int r=0;r<16;++r)P0[r]=__builtin_amdgcn_exp2f(P0[r]); }while(0)
  #define RESC() do{ if(resc){ asm volatile("s_waitcnt lgkmcnt(0)":::"memory"); \
      _Pragma("unroll") for(int d_=0;d_<2;++d_) _Pragma("unroll") for(int r=0;r<16;++r)o[d_][r]*=wsf[crow(r,hi)]; } }while(0)
  f32x16 pA0,pA1,pB0,pB1;
  int sl_prev=0,sl_cur=0,sl_next=SLOTB;
  #define ROT() do{sl_prev=sl_cur;sl_cur=sl_next;sl_next=(sl_next==(NSLOT-1)*SLOTB)?0:sl_next+SLOTB;}while(0)
  DMA_K(2,2*SLOTB);
  WAIT_BAR(3);
  qkt(pA0,pA1,Kbase,qr,negm,r32,hi);asm volatile("s_nop 15\n\ts_nop 7":"+v"(pA0),"+v"(pA1));CMASK(pA0,pA1,0);
  START(pA0,pA1);
  _Pragma("unroll") for(int r=0;r<16;++r)pA1[r]=__builtin_amdgcn_exp2f(pA1[r]);
  WAIT_BAR(0);
  DMA_K(3,0);DMA_V(1,SLOTB);
  ROT();
  kload8(kf,kp0+sl_cur);
  WAIT_BAR(2);
  s16x4 vlo[8],vhi[8]; u32x4 pw0,pw1,pw2,pw3;
  #define PKW(P,B) cvtpk_s(P[B],P[B+1])
  #define PAF(k) __builtin_bit_cast(bf16x8,pw##k)
  #define VFR(i) (bf16x8){vlo[i][0],vlo[i][1],vlo[i][2],vlo[i][3],vhi[i][0],vhi[i][1],vhi[i][2],vhi[i][3]}
  #define PIN(x) asm volatile("":"+v"(x))
  #define MX3(a,b,c) __builtin_fmaxf(__builtin_fmaxf((a),(b)),(c))
  #define GAPA(MF,A0,A1,A2,A3,W0,W1,PW) do{ MF; sacc+=A0; sacc+=A1; sacc+=A2; sacc+=A3; PIN(sacc); W0; W1; PIN(PW); SBAR(); }while(0)
  #define EX(v) __builtin_amdgcn_exp2f(v)
  #define GAPB(MF,X,B) do{ MF; X[B]=EX(X[B]); X[B+1]=EX(X[B+1]); X[B+2]=EX(X[B+2]); X[B+3]=EX(X[B+3]); PIN(X); SBAR(); }while(0)
  #define VRD(i) do{ vlo[i]=vtr(vp_+(((i)>>2)*4096+((i)&3)*1024)); vhi[i]=vtr(vp_+(((i)>>2)*4096+((i)&3)*1024+512)); }while(0)
  #define KRD(G,j) do{ if(G){ kload2(kf,kp0+sl_next,j); SBAR(); } }while(0)
  #define STEP(C0,C1,P0,P1,t,GK,GV,GL) do{ SBAR(); \
    const lds_cptr vp_=vp0+sl_prev; \
    VRD(0); SBAR(); float sacc=(P0[0]+P0[1]); \
    GAPA(C0=__builtin_amdgcn_mfma_f32_32x32x16_bf16(kf[0],qr[0],negm,0,0,0), P0[2],P0[3],P0[4],P0[5],     pw0[0]=PKW(P0,0), pw0[1]=PKW(P0,2), pw0); \
    VRD(4); SBAR(); GAPA(C1=__builtin_amdgcn_mfma_f32_32x32x16_bf16(kf[1],qr[0],negm,0,0,0), P0[6],P0[7],P0[8],P0[9],     pw0[2]=PKW(P0,4), pw0[3]=PKW(P0,6), pw0); \
    VRD(1); SBAR(); GAPA(C0=__builtin_amdgcn_mfma_f32_32x32x16_bf16(kf[2],qr[1],C0,0,0,0),   P0[10],P0[11],P0[12],P0[13], pw1[0]=PKW(P0,8), pw1[1]=PKW(P0,10), pw1); \
    VRD(5); SBAR(); GAPA(C1=__builtin_amdgcn_mfma_f32_32x32x16_bf16(kf[3],qr[1],C1,0,0,0),   P0[14],P0[15],P1[0],P1[1],   pw1[2]=PKW(P0,12),pw1[3]=PKW(P0,14), pw1); \
    VRD(2); SBAR(); GAPA(C0=__builtin_amdgcn_mfma_f32_32x32x16_bf16(kf[4],qr[2],C0,0,0,0),   P1[2],P1[3],P1[4],P1[5],     pw2[0]=PKW(P1,0), pw2[1]=PKW(P1,2), pw2); \
    VRD(6); SBAR(); GAPA(C1=__builtin_amdgcn_mfma_f32_32x32x16_bf16(kf[5],qr[2],C1,0,0,0),   P1[6],P1[7],P1[8],P1[9],     pw2[2]=PKW(P1,4), pw2[3]=PKW(P1,6), pw2); \
    VRD(3); SBAR(); GAPA(C0=__builtin_amdgcn_mfma_f32_32x32x16_bf16(kf[6],qr[3],C0,0,0,0),   P1[10],P1[11],P1[12],P1[13], pw3[0]=PKW(P1,8), pw3[1]=PKW(P1,10), pw3); \
    VRD(7); SBAR(); GAPA(C1=__builtin_amdgcn_mfma_f32_32x32x16_bf16(kf[7],qr[3],C1,0,0,0),   P1[14],P1[15],0.f,0.f,       pw3[2]=PKW(P1,12),pw3[3]=PKW(P1,14), pw3); \
    l_reg+=sacc; \
    if(GK){DMA_K((t)+3,sl_cur);} if(GV){DMA_V((t)+1,sl_next);} \
    _Pragma("unroll") for(int r=0;r<16;++r){C0[r]-=mhat;C1[r]-=mhat;} \
    CMASK(C0,C1,t); \
    { float a=MX3(C0[0],C0[1],C1[0]),b=MX3(C0[2],C0[3],C1[1]); a=MX3(a,C1[2],C1[3]); \
      _Pragma("unroll") for(int r=4;r<16;r+=4){a=MX3(a,C0[r],C0[r+1]);b=MX3(b,C0[r+2],C0[r+3]);a=MX3(a,C1[r],C1[r+1]);b=MX3(b,C1[r+2],C1[r+3]);} \
      float rm=__builtin_fmaxf(a,b); { auto rr=__builtin_amdgcn_permlane32_swap(__float_as_uint(rm),__float_as_uint(rm),false,false); rm=__builtin_fmaxf(__uint_as_float(rr[0]),__uint_as_float(rr[1])); } \
      resc=false; \
      if(__builtin_expect(__any(rm>(float)THRL),0)){ const float dl=__builtin_fmaxf(rm,0.f); mhat+=dl; \
        _Pragma("unroll") for(int r=0;r<16;++r){C0[r]-=dl;C1[r]-=dl;} \
        const float f=__builtin_amdgcn_exp2f(-dl); l_reg*=f; if(hi==0)wsf[r32]=f; resc=true; } } \
    SBAR(); \
    GAPB(o[0]=__builtin_amdgcn_mfma_f32_32x32x16_bf16(PAF(0),VFR(0),o[0],0,0,0), C0,0); \
    GAPB(o[1]=__builtin_amdgcn_mfma_f32_32x32x16_bf16(PAF(0),VFR(4),o[1],0,0,0), C0,4); \
    KRD(GL,0); GAPB(o[0]=__builtin_amdgcn_mfma_f32_32x32x16_bf16(PAF(1),VFR(1),o[0],0,0,0), C0,8); \
    KRD(GL,1); GAPB(o[1]=__builtin_amdgcn_mfma_f32_32x32x16_bf16(PAF(1),VFR(5),o[1],0,0,0), C0,12); \
    KRD(GL,2); GAPB(o[0]=__builtin_amdgcn_mfma_f32_32x32x16_bf16(PAF(2),VFR(2),o[0],0,0,0), C1,0); \
    KRD(GL,3); GAPB(o[1]=__builtin_amdgcn_mfma_f32_32x32x16_bf16(PAF(2),VFR(6),o[1],0,0,0), C1,4); \
    GAPB(o[0]=__builtin_amdgcn_mfma_f32_32x32x16_bf16(PAF(3),VFR(3),o[0],0,0,0), C1,8); \
    GAPB(o[1]=__builtin_amdgcn_mfma_f32_32x32x16_bf16(PAF(3),VFR(7),o[1],0,0,0), C1,12); \
    }while(0)
  int t=1;
  #undef CMASK
  #define CMASK(P0,P1,t) do{}while(0)
  for(;t+5<NT;t+=2){
    STEP(pB0,pB1,pA0,pA1,t,true,true,true);     WAIT_BAR(2); RESC(); ROT();
    STEP(pA0,pA1,pB0,pB1,t+1,true,true,true);   WAIT_BAR(2); RESC(); ROT();
  }
  #undef CMASK
  #define CMASK(P0,P1,t) do{int jb_=(t)-(NT-4); if(jb_>=0)cmask(P0,P1,jb_,qrel,hi);}while(0)
  #define ENDW(tt) do{ if((tt)+3<NT){WAIT_BAR(2);} else if((tt)+2<NT){WAIT_BAR(1);} else {WAIT_BAR(0);} }while(0)
  for(;t+1<NT;t+=2){
    STEP(pB0,pB1,pA0,pA1,t,(t+3<NT),(t+1<NT),(t+1<NT));       ENDW(t);   RESC(); ROT();
    STEP(pA0,pA1,pB0,pB1,t+1,(t+4<NT),(t+2<NT),(t+2<NT));     ENDW(t+1); RESC(); ROT();
  }
  STEP(pB0,pB1,pA0,pA1,NT-1,false,false,false); RESC();
  { float sacc=pB0[0]+pB0[1]; _Pragma("unroll") for(int r=2;r<16;++r)sacc+=pB0[r]; _Pragma("unroll") for(int r=0;r<16;++r)sacc+=pB1[r]; l_reg+=sacc;
    pw0=(u32x4){PKW(pB0,0),PKW(pB0,2),PKW(pB0,4),PKW(pB0,6)};pw1=(u32x4){PKW(pB0,8),PKW(pB0,10),PKW(pB0,12),PKW(pB0,14)};pw2=(u32x4){PKW(pB1,0),PKW(pB1,2),PKW(pB1,4),PKW(pB1,6)};pw3=(u32x4){PKW(pB1,8),PKW(pB1,10),PKW(pB1,12),PKW(pB1,14)};
    SBAR(); pv(o,vb0+sl_cur,PAF(0),PAF(1),PAF(2),PAF(3)); }
  #undef PKW
  #undef PAF
  #undef VFR
  #undef PIN
  #undef MX3
  #undef GAPA
  #undef GAPB
  #undef EX
  #undef VRD
  #undef KRD
  #undef STEP
  #undef ENDW
  {auto rr=__builtin_amdgcn_permlane32_swap(__float_as_uint(l_reg),__float_as_uint(l_reg),false,false);l_reg=__uint_as_float(rr[0])+__uint_as_float(rr[1]);}
  if(hi==0)wsf[32+r32]=l_reg;asm volatile("s_waitcnt lgkmcnt(0)":::"memory");
  float rli[16];
  #pragma unroll
  for(int r=0;r<16;++r)rli[r]=__builtin_amdgcn_rcpf(wsf[32+crow(r,hi)]);
  { bf16*hold=(bf16*)(shm+LDS_HOLD)+wid*4096;
    #pragma unroll
    for(int r=0;r<16;++r){const int orow=crow(r,hi);
      #pragma unroll
      for(int d0=0;d0<2;++d0){ bf16*hp=hold+orow*128+fcol+d0*32+r32; float v=o[d0][r]*rli[r];
        if(mode){ v=__bfloat162float(*hp)-lam*v; } *hp=__float2bfloat16(v);} }
    asm volatile("s_waitcnt lgkmcnt(0)":::"memory"); }
  asm volatile("s_waitcnt lgkmcnt(0)\n\ts_barrier":::"memory");
  #undef DMA_K
  #undef DMA_V
  #undef CMASK
  #undef START
  #undef RESC
  #undef ROT
}
#undef SBAR
#undef WAIT_BAR
}

struct Args { const float* in[24]; float* out; unsigned char* ws; int ph_lo, ph_hi, flags, pad; };
typedef __attribute__((address_space(4))) const char kchar;
__device__ __forceinline__ kchar* karg_base() { kchar* p = (kchar*)__builtin_amdgcn_kernarg_segment_ptr(); asm volatile("" : "+s"(p)); return p; }
__device__ __forceinline__ const float* karg_in(int i) { typedef const float* fp; return *(__attribute__((address_space(4))) const fp*)(karg_base() + 8 * i); }
__device__ __forceinline__ float* karg_out() { typedef float* fp; return *(__attribute__((address_space(4))) const fp*)(karg_base() + 192); }
__device__ __forceinline__ unsigned char* karg_ws() { typedef unsigned char* up; return *(__attribute__((address_space(4))) const up*)(karg_base() + 200); }
__device__ __forceinline__ int karg_int(int off) { return *(__attribute__((address_space(4))) const int*)(karg_base() + off); }
__device__ __forceinline__ int karg_flags() { return karg_int(216); }
static_assert(sizeof(Args) == 224, "kernarg layout: in[24] @0, out @192, ws @200, ph_lo @208, ph_hi @212, flags @216, pad @220");
__device__ __forceinline__ int gemm_probe_flags() { return karg_flags(); }
enum { I_X = 0, I_N1G, I_WIN, I_GMVG, I_GMWS, I_GMB, I_CONVW, I_CONVB, I_IGB, I_FGB, I_MLNG, I_QNG, I_KNG, I_LAM, I_SUBG, I_WOUT, I_N2G, I_WRG, I_BRG, I_WRE, I_BRE, I_WG, I_WU, I_WD };

__device__ __forceinline__ s16x4 tr16(const LAS bf16* p) { return __builtin_bit_cast(s16x4, __builtin_amdgcn_ds_read_tr16_b64_v4i16((LAS s16x4*)p)); }
__device__ __forceinline__ int crow(int r, int hi) { return (r & 3) + 8 * (r >> 2) + 4 * hi; }
#define MFMA32(a, b, c) __builtin_amdgcn_mfma_f32_32x32x16_bf16((a), (b), (c), 0, 0, 0)
#define MFMA16(a, b, c) __builtin_amdgcn_mfma_f32_16x16x32_bf16((a), (b), (c), 0, 0, 0)
__device__ __forceinline__ bf16x8 mk8(s16x4 lo, s16x4 hi) { return (bf16x8){lo[0], lo[1], lo[2], lo[3], hi[0], hi[1], hi[2], hi[3]}; }
__device__ __forceinline__ void unpack8(const v4u w, float (&x)[8]) { x[0] = lo_f(w.x); x[1] = hi_f(w.x); x[2] = lo_f(w.y); x[3] = hi_f(w.y); x[4] = lo_f(w.z); x[5] = hi_f(w.z); x[6] = lo_f(w.w); x[7] = hi_f(w.w); }
__device__ __forceinline__ v4u pack8(const float (&x)[8]) { v4u w; w.x = pk2(x[0], x[1]); w.y = pk2(x[2], x[3]); w.z = pk2(x[4], x[5]); w.w = pk2(x[6], x[7]); return w; }

__device__ __forceinline__ void tr_tile(const float* W, int ldw, int k0, int nsrc0, bf16* WT, int Kdst, int ndst0, LAS float* scr, int lane) {
#pragma unroll
    for (int i = 0; i < 16; ++i) {
        const int kk = 4 * i + (lane >> 4);
        const f32x4 v = *(const GAS f32x4*)(W + (size_t)(k0 + kk) * ldw + nsrc0 + 4 * (lane & 15));
        LAS float* d = scr + kk * 65 + 4 * (lane & 15);
        d[0] = v.x; d[1] = v.y; d[2] = v.z; d[3] = v.w;
    }
    LDS_WAIT(); asm volatile("" ::: "memory");
#pragma unroll
    for (int j = 0; j < 8; ++j) {
        const int n = 8 * j + (lane >> 3), c = lane & 7;
        const LAS float* s = scr + (8 * c) * 65 + n;
        v4u o; o.x = pk2(s[0 * 65], s[1 * 65]); o.y = pk2(s[2 * 65], s[3 * 65]); o.z = pk2(s[4 * 65], s[5 * 65]); o.w = pk2(s[6 * 65], s[7 * 65]);
        *(GAS v4u*)(WT + (size_t)(ndst0 + n) * Kdst + k0 + 8 * c) = o;
    }
    LDS_WAIT(); asm volatile("" ::: "memory");
}
__device__ __forceinline__ void tr8_load(f32x4 (&v)[16], const float* W, int ldw, int k0, int nsrc0, int lane) {
#pragma unroll
    for (int i = 0; i < 16; ++i) v[i] = *(const GAS f32x4*)(W + (size_t)(k0 + 4 * i + (lane >> 4)) * ldw + nsrc0 + 4 * (lane & 15));
}
__device__ __forceinline__ void tr8_finish(const f32x4 (&v)[16], int k0, unsigned char* WT8, int Kdst, int ndst0, float scale, LAS float* scr, int lane) {
#pragma unroll
    for (int i = 0; i < 16; ++i) { LAS float* d = scr + (4 * i + (lane >> 4)) * 65 + 4 * (lane & 15);
        d[0] = v[i].x * scale; d[1] = v[i].y * scale; d[2] = v[i].z * scale; d[3] = v[i].w * scale; }
    LDS_WAIT(); asm volatile("" ::: "memory");
#pragma unroll
    for (int j = 0; j < 4; ++j) {
        const int n = 16 * j + (lane >> 2), c = lane & 3;
        const LAS float* s = scr + (16 * c) * 65 + n;
        v4u o; o.x = pk_fp8x4(s[0 * 65], s[1 * 65], s[2 * 65], s[3 * 65]); o.y = pk_fp8x4(s[4 * 65], s[5 * 65], s[6 * 65], s[7 * 65]);
        o.z = pk_fp8x4(s[8 * 65], s[9 * 65], s[10 * 65], s[11 * 65]); o.w = pk_fp8x4(s[12 * 65], s[13 * 65], s[14 * 65], s[15 * 65]);
        *(GAS v4u*)(WT8 + (size_t)(ndst0 + n) * Kdst + k0 + 16 * c) = o;
    }
    LDS_WAIT(); asm volatile("" ::: "memory");
}
__device__ __forceinline__ void tr_tile_fp8(const float* W, int ldw, int k0, int nsrc0, unsigned char* WT8, int Kdst, int ndst0, float scale, LAS float* scr, int lane) {
    f32x4 v[16]; tr8_load(v, W, ldw, k0, nsrc0, lane); tr8_finish(v, k0, WT8, Kdst, ndst0, scale, scr, lane);
}
__device__ __forceinline__ void conv_phase(const Args& a, LAS unsigned char* lds, int gw, int NGW, int wave, int lane) {
    LAS float* scr = (LAS float*)(lds + wave * 16640);
    unsigned char* ws = karg_ws();
    constexpr int T_IN1 = 32 * 52, T_IN2 = 32 * 36, T_OUT = 32 * 32, T_L = T_IN1 + T_IN2 + T_OUT;
    for (int it = gw; it < 2 * T_L; it += NGW) {
        const int l = it / T_L; int r = it % T_L;
        if (G1_I8 && r < T_IN1 + T_IN2) continue;
        const float* w_in = karg_in(I_WIN) + (size_t)l * DMODEL * DIN; const float* w_out = karg_in(I_WOUT) + (size_t)l * 2048 * 2048;
        bf16* WIN_T = (bf16*)(ws + (l ? WS_WIN1 : WS_WIN)); bf16* WOUT_T = (bf16*)(ws + (l ? WS_WOUT1 : WS_WOUT));
        unsigned char* WIN8 = ws + WS_WIN8 + (size_t)l * 11 * MiB;
        if (r < T_IN1) { const int kb = r / 52, nb = r % 52; tr_tile(w_in, DIN, 64 * kb, 64 * nb, WIN_T, 2048, 64 * nb, scr, lane); if (G1_SPLIT) tr_tile_fp8(w_in, DIN, 64 * kb, 64 * nb, WIN8, 2048, 64 * nb, SC_WIN, scr, lane); continue; } r -= T_IN1;
        if (r < T_IN2) { const int kb = r / 36, nb = r % 36; tr_tile(w_in, DIN, 64 * kb, 3340 + 64 * nb, WIN_T, 2048, 3328 + 64 * nb, scr, lane); if (G1_SPLIT) tr_tile_fp8(w_in, DIN, 64 * kb, 3340 + 64 * nb, WIN8, 2048, 3328 + 64 * nb, SC_WIN, scr, lane); continue; } r -= T_IN2;
        { const int kb = r / 32, nb = r % 32; tr_tile(w_out, 2048, 64 * kb, 64 * nb, WOUT_T, 2048, 64 * nb, scr, lane); }
    }
    if (G1_I8) {
        unsigned* cm = (unsigned*)(ws + WS_CTL) + CW_CMAX;
        for (int j = gw; j < 2 * 88 * 8; j += NGW) {
            const int lj = j / 704, r = j % 704, strip = r >> 3, kc = r & 7, c4 = lane & 15, kq = lane >> 4;
            const int pc = 64 * strip + 4 * c4, sc_ = pc < 3328 ? pc : pc + 12;
            const float* wp = karg_in(I_WIN) + (size_t)lj * DMODEL * DIN + (size_t)(256 * kc + kq) * DIN + sc_;
            f32x4 mx = {0.f, 0.f, 0.f, 0.f};
#pragma unroll 16
            for (int i = 0; i < 64; ++i) { const f32x4 v = *(const GAS f32x4*)(wp + (size_t)(4 * i) * DIN); mx.x = fmaxf(mx.x, fabsf(v.x)); mx.y = fmaxf(mx.y, fabsf(v.y)); mx.z = fmaxf(mx.z, fabsf(v.z)); mx.w = fmaxf(mx.w, fabsf(v.w)); }
#pragma unroll
            for (int o = 16; o < 64; o <<= 1) { mx.x = fmaxf(mx.x, sx(mx.x, o)); mx.y = fmaxf(mx.y, sx(mx.y, o)); mx.z = fmaxf(mx.z, sx(mx.z, o)); mx.w = fmaxf(mx.w, sx(mx.w, o)); }
            if (kq == 0) { unsigned* d = cm + 8192 * lj + pc; atomicMax(d, __float_as_uint(mx.x)); atomicMax(d + 1, __float_as_uint(mx.y)); atomicMax(d + 2, __float_as_uint(mx.z)); atomicMax(d + 3, __float_as_uint(mx.w)); }
        }
    }
    const int l = 0;
    if (l == 0) {
        const float invf[8] = {1.0f, 0.19392274474868576f, 0.03760603093086393f, 0.007292664737217109f, 0.001414213562373095f, 0.0002742481756762073f, 5.318295896944988e-05f, 1.031338537721246e-05f};
        float* rope = (float*)(ws + WS_ROPE);
        for (int i = gw * 64 + lane; i < SEQ * 8; i += NGW * 64) { const int pos = i >> 3, j = i & 7; float f = invf[0];
#pragma unroll
            for (int q = 1; q < 8; ++q) f = (j == q) ? invf[q] : f;
            const float ang = (float)pos * f; rope[pos * 16 + j] = cosf(ang); rope[pos * 16 + 8 + j] = sinf(ang); }
    }
    for (int i2 = gw * 64 + lane; i2 < 2 * (8192 + 24576); i2 += NGW * 64) {
        const int lf = i2 / (8192 + 24576), i = i2 % (8192 + 24576);
        const float* w_in = karg_in(I_WIN) + (size_t)lf * DMODEL * DIN; const float* w_rg = karg_in(I_WRG) + (size_t)lf * 2048 * 4; const float* w_re = karg_in(I_WRE) + (size_t)lf * 2048 * 32;
        v4u* RWG = (v4u*)(ws + WS_RWG + lf * RW_LSTRIDE); v4u* RWR = (v4u*)(ws + WS_RWR + lf * RW_LSTRIDE);
        const bool isg = i < 8192; const int ii = isg ? i : i - 8192;
        const int ln = ii & 63, ks = (ii >> 6) & 63, rest = ii >> 12;
        const int hl = isg ? rest : rest / 3, nt = isg ? 0 : rest % 3;
        const int n = ln & 15, q = ln >> 4, c = 16 * nt + n; float w[8];
        const bool valid = isg ? (c < 12) : (c < 36);
        const float* src = isg ? (w_in + SRC_GATE + (valid ? c : 0)) : (c < 4 ? (w_rg + c) : (w_re + (valid ? c - 4 : 0)));
        const size_t stride = isg ? (size_t)DIN : (c < 4 ? (size_t)4 : (size_t)32);
        float raw[8];
#pragma unroll
        for (int j = 0; j < 8; ++j) raw[j] = src[(size_t)(32 * ks + 8 * q + j) * stride];
#pragma unroll
        for (int j = 0; j < 8; ++j) { const float v = valid ? raw[j] : 0.f;
            const float h = bf2f(f2bf(v)); w[j] = hl ? (v - h) : h; }
        const v4u o = pack8(w);
        if (isg) RWG[ii] = o; else RWR[ii] = o;
    }
}

__device__ __forceinline__ void quant_win_phase(LAS unsigned char* lds, int gw, int NGW, int wave, int lane) {
    LAS float* scr = (LAS float*)(lds + wave * 16640);
    unsigned char* ws = karg_ws(); const unsigned* cm = (const unsigned*)(ws + WS_CTL) + CW_CMAX;
    for (int it = gw; it < 2 * 32 * 88; it += NGW) {
        const int lq = it / 2816, r = it % 2816, kb = r / 88, nb = r % 88, k0 = 64 * kb, n0 = 64 * nb, sn0 = n0 < 3328 ? n0 : n0 + 12;
        const float* W = karg_in(I_WIN) + (size_t)lq * DMODEL * DIN; signed char* Q = (signed char*)(ws + WS_WIN8 + (size_t)lq * 11 * MiB);
#pragma unroll
        for (int i = 0; i < 16; ++i) { const int kk = 4 * i + (lane >> 4);
            const f32x4 v = *(const GAS f32x4*)(W + (size_t)(k0 + kk) * DIN + sn0 + 4 * (lane & 15));
            LAS float* d = scr + kk * 65 + 4 * (lane & 15); d[0] = v.x; d[1] = v.y; d[2] = v.z; d[3] = v.w; }
        LDS_WAIT(); asm volatile("" ::: "memory");
#pragma unroll
        for (int j = 0; j < 4; ++j) {
            const int n = 16 * j + (lane >> 2), c = lane & 3;
            const float cmx = __uint_as_float(cm[8192 * lq + n0 + n]), inv = cmx > 0.f ? 127.0f / cmx : 0.f;
            const LAS float* sp = scr + (16 * c) * 65 + n; unsigned w[4];
#pragma unroll
            for (int d4 = 0; d4 < 4; ++d4) { unsigned pk = 0u;
#pragma unroll
                for (int e = 0; e < 4; ++e) pk |= ((unsigned)(int)__builtin_rintf(sp[(4 * d4 + e) * 65] * inv) & 0xffu) << (8 * e);
                w[d4] = pk; }
            *(GAS v4u*)(Q + (size_t)(n0 + n) * 2048 + k0 + 16 * c) = (v4u){w[0], w[1], w[2], w[3]};
        }
        LDS_WAIT(); asm volatile("" ::: "memory");
    }
}

constexpr int CONV_MOE_UNITS = (2 * 32 * 32 * 8 + 32 * 8 * 32) / 32;
__device__ __forceinline__ void conv_moe_unit(int c, int l, LAS unsigned char* lds, int wave, int lane_in) {
    int lane = lane_in; asm volatile("" : "+v"(lane));
    LAS float* scr = (LAS float*)(lds + wave * 16640);
    unsigned char* ws = karg_ws();
    const float* w_g = karg_in(I_WG) + (size_t)l * NEXP * 2048 * 512; const float* w_u = karg_in(I_WU) + (size_t)l * NEXP * 2048 * 512; const float* w_d = karg_in(I_WD) + (size_t)l * NEXP * 512 * 2048;
    unsigned char* WGU_T = ws + WS_WGU; unsigned char* WD_T = ws + WS_WD;
    constexpr int T_G = 32 * 32 * 8;
#define CM_DECODE(r_, W_, ldw_, k0_, n0_, D_, kd_, nd_, sc_) do { int r = (r_); \
        if (r < 2 * T_G) { const int which = r / T_G, r2 = r % T_G, e = r2 / 256, r3 = r2 % 256, kb = r3 / 8, nb = r3 % 8; \
            W_ = (which ? w_u : w_g) + (size_t)e * 2048 * 512; ldw_ = 512; k0_ = 64 * kb; n0_ = 64 * nb; D_ = WGU_T; kd_ = 2048; nd_ = e * 1024 + ((64 * nb) / 128) * 256 + which * 128 + ((64 * nb) % 128); sc_ = SC_WGU; } \
        else { r -= 2 * T_G; const int e = r / 256, r3 = r % 256, kb = r3 / 32, nb = r3 % 32; \
            W_ = w_d + (size_t)e * 512 * 2048; ldw_ = 2048; k0_ = 64 * kb; n0_ = 64 * nb; D_ = WD_T + (size_t)e * 2048 * 512; kd_ = 512; nd_ = 64 * nb; sc_ = SC_WD; } } while (0)
    const float* W0; int ldw0, k00, n00, kd0, nd0; unsigned char* D0; float sc0;
    CM_DECODE(32 * c + wave, W0, ldw0, k00, n00, D0, kd0, nd0, sc0);
    f32x4 va[16]; tr8_load(va, W0, ldw0, k00, n00, lane);
#pragma unroll 1
    for (int i = 0; i < 4; ++i) {
        const float* W1 = W0; int ldw1 = ldw0, k01 = k00, n01 = n00, kd1 = kd0, nd1 = nd0; unsigned char* D1 = D0; float sc1 = sc0;
        f32x4 vb[16];
        if (i + 1 < 4) { CM_DECODE(32 * c + 8 * (i + 1) + wave, W1, ldw1, k01, n01, D1, kd1, nd1, sc1); tr8_load(vb, W1, ldw1, k01, n01, lane); }
        tr8_finish(va, k00, D0, kd0, nd0, sc0, scr, lane);
        if (i + 1 < 4) {
#pragma unroll
            for (int q = 0; q < 16; ++q) va[q] = vb[q];
            W0 = W1; ldw0 = ldw1; k00 = k01; n00 = n01; kd0 = kd1; nd0 = nd1; D0 = D1; sc0 = sc1; }
    }
#undef CM_DECODE
    __syncthreads();
}

__device__ __forceinline__ void build_tp(const unsigned* cnt, volatile LAS int* tp, int tid) {
    if (tid < 64) {
        const int ln = hw_lane();
        const unsigned c = (ln < NEXP) ? __hip_atomic_load(cnt + ln, RLX_AGENT) : 0u;
        const int tiles = (int)((c + 255u) >> 8); int incl = tiles;
#pragma unroll
        for (int o = 1; o < 32; o <<= 1) { const int up = __builtin_amdgcn_ds_bpermute((ln - o) << 2, incl); if (ln >= o) incl += up; }
        if (ln < NEXP) tp[ln] = incl - tiles;
        if (ln == NEXP - 1) tp[NEXP] = incl;
    }
    __syncthreads();
}
template <int NT, bool COMBINE, int KB, bool A8 = false, bool XB16 = false, bool AB = false, bool Q8 = false>
__device__ __forceinline__ void norm_rows(int R0, const void* xin_, void* xout_, const unsigned char* Y, const v4u* route_prev, const LAS int* tp, bf16* Aout, const v4u* RW,
                                          LAS unsigned char* lds, f32x4 (&acc)[NT], float& rstd, int tid, bool noc, float* rowscale = nullptr) {
    constexpr int NB = 64 / KB, SL = KB * 2 * NT * 64, PPT = (SL + 511) / 512;
    const int lane = tid & 63, row = lane & 15, quad = lane >> 4; const size_t t = (size_t)R0 + row;
    const LAS float* gl = (const LAS float*)lds + quad * 8; LAS v4u* rwb = (LAS v4u*)(lds + 8192);
    const float* xp = (const float*)xin_ + t * 2048 + quad * 8; float* xo = (float*)xout_ + t * 2048 + quad * 8;
    const bf16* xp16 = (const bf16*)xin_ + t * 2048 + quad * 8; bf16* xo16 = (bf16*)xout_ + t * 2048 + quad * 8;
    float w0 = 0.f, w1 = 0.f; const unsigned char* y0 = Y; const unsigned char* y1 = Y;
    if constexpr (COMBINE) { const v4u r = route_prev[t]; const int s0 = tp[r.x >> 16] * 256 + (int)(r.x & 0xffffu), s1 = tp[r.y >> 16] * 256 + (int)(r.y & 0xffffu);
        w0 = __uint_as_float(r.z); w1 = __uint_as_float(r.w);
        if (noc) { w0 = 0.f; w1 = 0.f; }
        y0 = Y + (size_t)s0 * 2048 + quad * 8; y1 = Y + (size_t)s1 * 2048 + quad * 8; }
    bf16* ao = Aout + t * 2048 + quad * 8; unsigned char* ao8 = (unsigned char*)Aout + t * 2048 + quad * 8; unsigned char* ab8 = karg_ws() + WS_A8 + t * 2048 + quad * 8;
#define RW_GIDX(b_, j_, tb_) ((((tb_) + 512 * (j_)) / (KB * 64) * 64 + (b_) * KB) * 64 + ((tb_) + 512 * (j_)) % (KB * 64))
    float zz = 0.f; asm volatile("" : "+v"(zz));
#pragma unroll
    for (int n = 0; n < NT; ++n) acc[n] = (f32x4){zz, zz, zz, zz};
    float ss = 0.f, amax = 0.f;
    f32x4 xa[KB], xb[KB]; v4u xr[XB16 ? KB : 1]; v2u ya[COMBINE ? KB : 1], yb[COMBINE ? KB : 1]; v4u rwn[PPT];
    { int tb = tid; asm volatile("" : "+v"(tb));
#pragma unroll
    for (int j = 0; j < PPT; ++j) if (tb + 512 * j < SL) rwn[j] = RW[RW_GIDX(0, j, tb)]; }
#pragma unroll
    for (int k = 0; k < KB; ++k) { if constexpr (XB16) xr[k] = *(const GAS v4u*)(xp16 + k * 32); else { xa[k] = *(const GAS f32x4*)(xp + k * 32); xb[k] = *(const GAS f32x4*)(xp + k * 32 + 4); }
        if constexpr (COMBINE) { ya[k] = *(const GAS v2u*)(y0 + k * 32); yb[k] = *(const GAS v2u*)(y1 + k * 32); } }
#pragma unroll
    for (int j = 0; j < PPT; ++j) if (tid + 512 * j < SL) rwb[tid + 512 * j] = rwn[j];
    __syncthreads();
#pragma unroll 1
    for (int b = 0; b < NB; ++b) {
        f32x4 nxa[KB], nxb[KB]; v4u nxr[XB16 ? KB : 1]; v2u nya[COMBINE ? KB : 1], nyb[COMBINE ? KB : 1];
        const bool more = b + 1 < NB; const int kb1 = (b + 1) * KB;
        if (more) {
            int tb = tid; asm volatile("" : "+v"(tb));
#pragma unroll
            for (int j = 0; j < PPT; ++j) if (tb + 512 * j < SL) rwn[j] = RW[RW_GIDX(b + 1, j, tb)];
#pragma unroll
            for (int k = 0; k < KB; ++k) { if constexpr (XB16) nxr[k] = *(const GAS v4u*)(xp16 + (kb1 + k) * 32); else { nxa[k] = *(const GAS f32x4*)(xp + (kb1 + k) * 32); nxb[k] = *(const GAS f32x4*)(xp + (kb1 + k) * 32 + 4); }
                if constexpr (COMBINE) { nya[k] = *(const GAS v2u*)(y0 + (kb1 + k) * 32); nyb[k] = *(const GAS v2u*)(y1 + (kb1 + k) * 32); } }
        }
        const LAS v4u* cur = rwb + (b & 1) * SL + lane;
#pragma unroll
        for (int k = 0; k < KB; ++k) {
            const int ks = b * KB + k; f32x4 va, vb;
            if constexpr (XB16) { const v4u r_ = xr[k]; va = (f32x4){lo_f(r_.x), hi_f(r_.x), lo_f(r_.y), hi_f(r_.y)}; vb = (f32x4){lo_f(r_.z), hi_f(r_.z), lo_f(r_.w), hi_f(r_.w)}; } else { va = xa[k]; vb = xb[k]; }
            if constexpr (COMBINE) {
                float p_[8], q_[8]; unpack_fp8x8(ya[k], p_); unpack_fp8x8(yb[k], q_);
                va.x += w0 * p_[0] + w1 * q_[0]; va.y += w0 * p_[1] + w1 * q_[1]; va.z += w0 * p_[2] + w1 * q_[2]; va.w += w0 * p_[3] + w1 * q_[3];
                vb.x += w0 * p_[4] + w1 * q_[4]; vb.y += w0 * p_[5] + w1 * q_[5]; vb.z += w0 * p_[6] + w1 * q_[6]; vb.w += w0 * p_[7] + w1 * q_[7];
                if constexpr (XB16) { v4u w_; w_.x = pk2(va.x, va.y); w_.y = pk2(va.z, va.w); w_.z = pk2(vb.x, vb.y); w_.w = pk2(vb.z, vb.w); *(GAS v4u*)(xo16 + ks * 32) = w_;
                    va = (f32x4){lo_f(w_.x), hi_f(w_.x), lo_f(w_.y), hi_f(w_.y)}; vb = (f32x4){lo_f(w_.z), hi_f(w_.z), lo_f(w_.w), hi_f(w_.w)}; }
                else { *(GAS f32x4*)(xo + ks * 32) = va; *(GAS f32x4*)(xo + ks * 32 + 4) = vb; }
            }
            ss += (va.x * va.x + va.y * va.y) + (va.z * va.z + va.w * va.w) + (vb.x * vb.x + vb.y * vb.y) + (vb.z * vb.z + vb.w * vb.w);
            const f32x4 ga = *(const LAS f32x4*)(gl + ks * 32), gb = *(const LAS f32x4*)(gl + ks * 32 + 4);
            va = va * ga; vb = vb * gb;
            if constexpr (Q8) amax = fmaxf(amax, fmaxf(fmaxf(fmaxf(fabsf(va.x), fabsf(va.y)), fmaxf(fabsf(va.z), fabsf(va.w))), fmaxf(fmaxf(fabsf(vb.x), fabsf(vb.y)), fmaxf(fabsf(vb.z), fabsf(vb.w)))));
            v4u hi; hi.x = pk2(va.x, va.y); hi.y = pk2(va.z, va.w); hi.z = pk2(vb.x, vb.y); hi.w = pk2(vb.z, vb.w);
            v4u lo; lo.x = pk2(va.x - lo_f(hi.x), va.y - hi_f(hi.x)); lo.y = pk2(va.z - lo_f(hi.y), va.w - hi_f(hi.y)); lo.z = pk2(vb.x - lo_f(hi.z), vb.y - hi_f(hi.z)); lo.w = pk2(vb.z - lo_f(hi.w), vb.w - hi_f(hi.w));
            if constexpr (A8) { v2u w8; w8.x = pk_fp8x4(va.x, va.y, va.z, va.w); w8.y = pk_fp8x4(vb.x, vb.y, vb.z, vb.w); *(GAS v2u*)(ao8 + ks * 32) = w8; }
            else if constexpr (!Q8) *(GAS v4u*)(ao + ks * 32) = hi;
            if constexpr (AB) { v2u w8; w8.x = pk_fp8x4(va.x, va.y, va.z, va.w); w8.y = pk_fp8x4(vb.x, vb.y, vb.z, vb.w); *(GAS v2u*)(ab8 + ks * 32) = w8; }
            const bf16x8 ah = __builtin_bit_cast(bf16x8, hi), al = __builtin_bit_cast(bf16x8, lo);
#pragma unroll
            for (int n = 0; n < NT; ++n) {
                const bf16x8 bh = __builtin_bit_cast(bf16x8, cur[((0 * NT + n) * KB + k) * 64]), bl = __builtin_bit_cast(bf16x8, cur[((1 * NT + n) * KB + k) * 64]);
                acc[n] = MFMA16(ah, bh, acc[n]); acc[n] = MFMA16(al, bh, acc[n]); acc[n] = MFMA16(ah, bl, acc[n]);
            }
            __builtin_amdgcn_sched_barrier(0);
        }
        if (more) {
#pragma unroll
            for (int j = 0; j < PPT; ++j) if (tid + 512 * j < SL) rwb[((b + 1) & 1) * SL + tid + 512 * j] = rwn[j];
#pragma unroll
            for (int k = 0; k < KB; ++k) { if constexpr (XB16) xr[k] = nxr[k]; else { xa[k] = nxa[k]; xb[k] = nxb[k]; } if constexpr (COMBINE) { ya[k] = nya[k]; yb[k] = nyb[k]; } }
        }
        __syncthreads();
    }
    ss += sx(ss, 16); ss += sx(ss, 32);
    rstd = 1.0f / sqrtf(ss * (1.0f / 2048.0f) + EPS);
    if constexpr (Q8) {
        amax = fmaxf(amax, sx(amax, 16)); amax = fmaxf(amax, sx(amax, 32));
        const float qs = amax > 0.f ? 127.0f / amax : 0.f;
        asm volatile("s_waitcnt vmcnt(0)" ::: "memory");
        signed char* aq = (signed char*)Aout + t * 2048 + quad * 8;
#pragma unroll 1
        for (int b = 0; b < 16; ++b) {
            f32x4 qa[4], qb[4]; v4u qr[XB16 ? 4 : 1];
#pragma unroll
            for (int k = 0; k < 4; ++k) { const int ks = b * 4 + k; if constexpr (XB16) qr[k] = *(const GAS v4u*)((COMBINE ? (const bf16*)xo16 : xp16) + ks * 32); else { qa[k] = *(const GAS f32x4*)(xp + ks * 32); qb[k] = *(const GAS f32x4*)(xp + ks * 32 + 4); } }
#pragma unroll
            for (int k = 0; k < 4; ++k) { const int ks = b * 4 + k; f32x4 va, vb;
                if constexpr (XB16) { const v4u r_ = qr[k]; va = (f32x4){lo_f(r_.x), hi_f(r_.x), lo_f(r_.y), hi_f(r_.y)}; vb = (f32x4){lo_f(r_.z), hi_f(r_.z), lo_f(r_.w), hi_f(r_.w)}; } else { va = qa[k]; vb = qb[k]; }
                const f32x4 ga = *(const LAS f32x4*)(gl + ks * 32), gb = *(const LAS f32x4*)(gl + ks * 32 + 4);
                va = va * ga * qs; vb = vb * gb * qs;
                v2u w; w.x = ((unsigned)(int)__builtin_rintf(va.x) & 0xffu) | (((unsigned)(int)__builtin_rintf(va.y) & 0xffu) << 8) | (((unsigned)(int)__builtin_rintf(va.z) & 0xffu) << 16) | ((unsigned)(int)__builtin_rintf(va.w) << 24);
                w.y = ((unsigned)(int)__builtin_rintf(vb.x) & 0xffu) | (((unsigned)(int)__builtin_rintf(vb.y) & 0xffu) << 8) | (((unsigned)(int)__builtin_rintf(vb.z) & 0xffu) << 16) | ((unsigned)(int)__builtin_rintf(vb.w) << 24);
                *(GAS v2u*)(aq + ks * 32) = w; }
        }
        *rowscale = rstd * amax * (1.0f / 127.0f);
    }
#undef RW_GIDX
}
__device__ __forceinline__ void stage_gain(const float* g, LAS unsigned char* lds, int tid) { *(LAS f32x4*)(lds + tid * 16) = *(const GAS f32x4*)(g + tid * 4); __syncthreads(); }
template <bool COMBINE>
__device__ __forceinline__ void norm1_phase(const Args& a, int l, const LAS int* tp, LAS unsigned char* lds, int vcu, int G, int wave, int tid) {
    unsigned char* ws = karg_ws(); const int lane = tid & 63;
    const void* xin = COMBINE ? (const void*)(ws + WS_XB) : (const void*)karg_in(I_X);
    bf16* A = (bf16*)(ws + (G1_I8 ? WS_A8 : WS_BUFA)); float* RSTD = (float*)(ws + WS_RSTD); float* GATES = (float*)(ws + WS_GATES);
    stage_gain(karg_in(I_N1G) + l * 2048, lds, tid);
    for (int grp0 = vcu * 8; grp0 < MTOK / 16; grp0 += G * 8) {
        const int grp = grp0 + wave; f32x4 acc[1]; float rstd, rsc;
        norm_rows<1, COMBINE, COMBINE ? 2 : (G1_I8 ? 4 : 8), false, COMBINE, G1_SPLIT != 0, G1_I8 != 0>(grp * 16, xin, ws + WS_XB, (const unsigned char*)(ws + WS_Y), (const v4u*)(ws + WS_ROUTE), tp, A, (const v4u*)(ws + WS_RWG + l * RW_LSTRIDE), lds, acc, rstd, tid, (karg_flags() & 8) != 0, &rsc);
        if (!G1_I8) rsc = rstd;
        const int quad = lane >> 4;
        if (quad == 0) RSTD[grp * 16 + lane] = rsc;
#pragma unroll
        for (int j = 0; j < 4; ++j) { const float rs = sidx(rstd, quad * 4 + j); GATES[(size_t)(grp * 16 + quad * 4 + j) * 16 + (lane & 15)] = acc[0][j] * rs; }
    }
}
template <bool COMBINE>
__device__ __forceinline__ void norm1_i8_phase(int l, const LAS int* tp, LAS unsigned char* lds, int vcu, int G, int wave, int tid) {
    unsigned char* ws = karg_ws(); const int lane = tid & 63, row = lane & 15, quad = lane >> 4;
    const float* xin = karg_in(I_X); bf16* XB = (bf16*)(ws + WS_XB); const unsigned char* Y = ws + WS_Y; const v4u* route_prev = (const v4u*)(ws + WS_ROUTE);
    signed char* A8 = (signed char*)(ws + WS_A8); float* RSTD = (float*)(ws + WS_RSTD); float* GATES = (float*)(ws + WS_GATES);
    const bool noc = (karg_flags() & 8) != 0;
    LAS v4u* rwl = (LAS v4u*)(lds + 8192); LAS float* part = (LAS float*)(lds + 8192 + 131072); LAS float* dpart = part + 256;
    { const v4u* RW = (const v4u*)(ws + WS_RWG + l * RW_LSTRIDE);
#pragma unroll
      for (int j = 0; j < 16; ++j) rwl[tid + 512 * j] = RW[tid + 512 * j]; }
    stage_gain(karg_in(I_N1G) + l * 2048, lds, tid);
    const LAS float* gl = (const LAS float*)lds + 256 * wave + 8 * quad;
    const int c0 = 256 * wave + 8 * quad;
    v4u rnext = {0u, 0u, 0u, 0u};
    if constexpr (COMBINE) { if (vcu < MTOK / 16) rnext = route_prev[(size_t)vcu * 16 + row]; }
#pragma unroll 1
    for (int grp = vcu; grp < MTOK / 16; grp += G) {
        const size_t t = (size_t)grp * 16 + row;
        float xg[8][8]; float ss = 0.f, amax = 0.f; f32x4 acc = {0.f, 0.f, 0.f, 0.f};
        if constexpr (!COMBINE) {
            f32x4 xa[8], xb[8];
#pragma unroll
            for (int ks = 0; ks < 8; ++ks) { xa[ks] = *(const GAS f32x4*)(xin + t * 2048 + c0 + 32 * ks); xb[ks] = *(const GAS f32x4*)(xin + t * 2048 + c0 + 32 * ks + 4); }
#pragma unroll
            for (int ks = 0; ks < 8; ++ks) { xg[ks][0] = xa[ks].x; xg[ks][1] = xa[ks].y; xg[ks][2] = xa[ks].z; xg[ks][3] = xa[ks].w; xg[ks][4] = xb[ks].x; xg[ks][5] = xb[ks].y; xg[ks][6] = xb[ks].z; xg[ks][7] = xb[ks].w; }
        } else {
            const v4u r = rnext; if (grp + G < MTOK / 16) rnext = route_prev[(size_t)(grp + G) * 16 + row];
            const int s0 = tp[r.x >> 16] * 256 + (int)(r.x & 0xffffu), s1 = tp[r.y >> 16] * 256 + (int)(r.y & 0xffffu);
            float w0 = __uint_as_float(r.z), w1 = __uint_as_float(r.w); if (noc) { w0 = 0.f; w1 = 0.f; }
            v4u xr[8]; v2u ya[8], yb[8];
#pragma unroll
            for (int ks = 0; ks < 8; ++ks) { xr[ks] = *(const GAS v4u*)(XB + t * 2048 + c0 + 32 * ks); ya[ks] = *(const GAS v2u*)(Y + (size_t)s0 * 2048 + c0 + 32 * ks); yb[ks] = *(const GAS v2u*)(Y + (size_t)s1 * 2048 + c0 + 32 * ks); }
#pragma unroll
            for (int ks = 0; ks < 8; ++ks) { float p_[8], q_[8], x_[8]; unpack8(xr[ks], x_); unpack_fp8x8(ya[ks], p_); unpack_fp8x8(yb[ks], q_);
#pragma unroll
                for (int e = 0; e < 8; ++e) x_[e] += w0 * p_[e] + w1 * q_[e];
                const v4u wb = pack8(x_); *(GAS v4u*)(XB + t * 2048 + c0 + 32 * ks) = wb;
                unpack8(wb, x_);
#pragma unroll
                for (int e = 0; e < 8; ++e) xg[ks][e] = x_[e]; }
        }
#pragma unroll
        for (int ks = 0; ks < 8; ++ks) {
            const f32x4 ga = *(const LAS f32x4*)(gl + 32 * ks), gb = *(const LAS f32x4*)(gl + 32 * ks + 4); const float g8[8] = {ga.x, ga.y, ga.z, ga.w, gb.x, gb.y, gb.z, gb.w};
#pragma unroll
            for (int e = 0; e < 8; ++e) { ss += xg[ks][e] * xg[ks][e]; xg[ks][e] *= g8[e]; amax = fmaxf(amax, fabsf(xg[ks][e])); }
            v4u hi; hi.x = pk2(xg[ks][0], xg[ks][1]); hi.y = pk2(xg[ks][2], xg[ks][3]); hi.z = pk2(xg[ks][4], xg[ks][5]); hi.w = pk2(xg[ks][6], xg[ks][7]);
            v4u lo; lo.x = pk2(xg[ks][0] - lo_f(hi.x), xg[ks][1] - hi_f(hi.x)); lo.y = pk2(xg[ks][2] - lo_f(hi.y), xg[ks][3] - hi_f(hi.y)); lo.z = pk2(xg[ks][4] - lo_f(hi.z), xg[ks][5] - hi_f(hi.z)); lo.w = pk2(xg[ks][6] - lo_f(hi.w), xg[ks][7] - hi_f(hi.w));
            const int ksg = 8 * wave + ks;
            const bf16x8 bh = __builtin_bit_cast(bf16x8, rwl[ksg * 64 + lane]), bl = __builtin_bit_cast(bf16x8, rwl[(64 + ksg) * 64 + lane]);
            const bf16x8 ah = __builtin_bit_cast(bf16x8, hi), al = __builtin_bit_cast(bf16x8, lo);
            acc = MFMA16(ah, bh, acc); acc = MFMA16(al, bh, acc); acc = MFMA16(ah, bl, acc);
        }
        ss += sx(ss, 16); ss += sx(ss, 32); amax = fmaxf(amax, sx(amax, 16)); amax = fmaxf(amax, sx(amax, 32));
        if (quad == 0) { part[(wave * 16 + row) * 2] = ss; part[(wave * 16 + row) * 2 + 1] = amax; }
        *(LAS f32x4*)(dpart + wave * 256 + lane * 4) = acc;
        __syncthreads();
        float sst = 0.f, amt = 0.f;
#pragma unroll
        for (int w8 = 0; w8 < 8; ++w8) { sst += part[(w8 * 16 + row) * 2]; amt = fmaxf(amt, part[(w8 * 16 + row) * 2 + 1]); }
        const float rstd = 1.0f / sqrtf(sst * (1.0f / 2048.0f) + EPS), qs = amt > 0.f ? 127.0f / amt : 0.f;
        if (wave == 0) {
            f32x4 d = {0.f, 0.f, 0.f, 0.f};
#pragma unroll
            for (int w8 = 0; w8 < 8; ++w8) d = d + *(const LAS f32x4*)(dpart + w8 * 256 + lane * 4);
            if (quad == 0) RSTD[t] = rstd * amt * (1.0f / 127.0f);
#pragma unroll
            for (int j = 0; j < 4; ++j) { const float rs = sidx(rstd, quad * 4 + j); GATES[(size_t)(grp * 16 + quad * 4 + j) * 16 + (lane & 15)] = d[j] * rs; }
        }
#pragma unroll
        for (int ks = 0; ks < 8; ++ks) { v2u w;
            w.x = ((unsigned)(int)__builtin_rintf(xg[ks][0] * qs) & 0xffu) | (((unsigned)(int)__builtin_rintf(xg[ks][1] * qs) & 0xffu) << 8) | (((unsigned)(int)__builtin_rintf(xg[ks][2] * qs) & 0xffu) << 16) | ((unsigned)(int)__builtin_rintf(xg[ks][3] * qs) << 24);
            w.y = ((unsigned)(int)__builtin_rintf(xg[ks][4] * qs) & 0xffu) | (((unsigned)(int)__builtin_rintf(xg[ks][5] * qs) & 0xffu) << 8) | (((unsigned)(int)__builtin_rintf(xg[ks][6] * qs) & 0xffu) << 16) | ((unsigned)(int)__builtin_rintf(xg[ks][7] * qs) << 24);
            *(GAS v2u*)(A8 + t * 2048 + c0 + 32 * ks) = w; }
        __syncthreads();
    }
}
__device__ __forceinline__ void norm2_phase(const Args& a, int l, LAS unsigned char* lds, int vcu, int G, int wave, int tid) {
    unsigned char* ws = karg_ws(); const int lane = tid & 63;
    const float* b_rg = karg_in(I_BRG) + l * 4; const float* b_re = karg_in(I_BRE) + l * 32;
    bf16* A = (bf16*)(ws + WS_A8); float* RSTD = (float*)(ws + WS_RSTD);
    unsigned* cnt = (unsigned*)(ws + WS_CTL) + CW_CNT + 64 * l; int* list = (int*)(ws + WS_LIST); v4u* route = (v4u*)(ws + WS_ROUTE);
    LAS unsigned* lcnt = (LAS unsigned*)(lds + 8192 + 98304 + 8 * 3072); LAS unsigned* lbase = lcnt + 32;
    if (tid < 32) lcnt[tid] = 0u;
    stage_gain(karg_in(I_N2G) + l * 2048, lds, tid);
    for (int grp0 = vcu * 8; grp0 < MTOK / 16; grp0 += G * 8) {
        const int grp = grp0 + wave; f32x4 acc[3]; float rstd;
        norm_rows<3, false, 8, true, true>(grp * 16, ws + WS_XB, nullptr, nullptr, nullptr, nullptr, A, (const v4u*)(ws + WS_RWR + l * RW_LSTRIDE), lds, acc, rstd, tid, false);
        LAS float* scr = (LAS float*)(lds + 8192 + 98304 + wave * 3072);
        const int ln2 = hw_lane();
        const int quad = ln2 >> 4;
        if (quad == 0) RSTD[grp * 16 + ln2] = rstd;
#pragma unroll
        for (int n = 0; n < 3; ++n)
#pragma unroll
            for (int j = 0; j < 4; ++j) scr[(quad * 4 + j) * 48 + n * 16 + (ln2 & 15)] = acc[n][j];
        LDS_WAIT(); asm volatile("" ::: "memory");
        int e1 = 0, e2 = 0; unsigned l1 = 0u, l2 = 0u; float w1v = 0.f, w2v = 0.f;
        if (ln2 < 16) {
            const LAS float* L = scr + ln2 * 48;
            float lg[4];
#pragma unroll
            for (int c = 0; c < 4; ++c) lg[c] = L[c] * rstd + b_rg[c];
            int gi = 0; float gm = lg[0];
#pragma unroll
            for (int c = 1; c < 4; ++c) if (lg[c] > gm) { gm = lg[c]; gi = c; }
            float gs = 0.f;
#pragma unroll
            for (int c = 0; c < 4; ++c) gs += __expf(lg[c] - gm);
            const float pg = 1.0f / gs;
            float le[8];
#pragma unroll
            for (int j = 0; j < 8; ++j) le[j] = L[4 + gi * 8 + j] * rstd + b_re[gi * 8 + j];
            int i1 = 0; float v1 = le[0];
#pragma unroll
            for (int j = 1; j < 8; ++j) if (le[j] > v1) { v1 = le[j]; i1 = j; }
            int i2 = -1; float v2 = -INFINITY;
#pragma unroll
            for (int j = 0; j < 8; ++j) if (j != i1 && le[j] > v2) { v2 = le[j]; i2 = j; }
            const float d = __expf(v2 - v1), wa = pg / (1.0f + d), wb = pg * d / (1.0f + d);
            e1 = gi * 8 + i1; e2 = gi * 8 + i2; w1v = wa; w2v = wb;
            l1 = __hip_atomic_fetch_add(lcnt + e1, 1u, __ATOMIC_RELAXED, __HIP_MEMORY_SCOPE_WORKGROUP); l2 = __hip_atomic_fetch_add(lcnt + e2, 1u, __ATOMIC_RELAXED, __HIP_MEMORY_SCOPE_WORKGROUP);
        }
        __syncthreads();
        { const int tt = wave * 64 + ln2;
            if (tt < NEXP) { const unsigned n = lcnt[tt]; lbase[tt] = n ? __hip_atomic_fetch_add(cnt + tt, n, RLX_AGENT) : 0u; lcnt[tt] = 0u; } }
        __syncthreads();
        if (ln2 < 16) {
            const int t = grp * 16 + ln2; const unsigned r1 = lbase[e1] + l1, r2 = lbase[e2] + l2;
            list[e1 * 32768 + (int)r1] = t; list[e2 * 32768 + (int)r2] = t;
            v4u ro; ro.x = ((unsigned)e1 << 16) | r1; ro.y = ((unsigned)e2 << 16) | r2; ro.z = __builtin_bit_cast(unsigned, w1v); ro.w = __builtin_bit_cast(unsigned, w2v);
            route[t] = ro;
        }
        __syncthreads();
    }
}
__device__ __forceinline__ void norm2_sp_phase(int l, LAS unsigned char* lds, int vcu, int G, int wave, int tid) {
    unsigned char* ws = karg_ws(); const int lane = tid & 63, row = lane & 15, quad = lane >> 4;
    const float* b_rg = karg_in(I_BRG) + l * 4; const float* b_re = karg_in(I_BRE) + l * 32;
    const bf16* XB = (const bf16*)(ws + WS_XB); unsigned char* A8 = ws + WS_A8; float* RSTD = (float*)(ws + WS_RSTD);
    unsigned* cnt = (unsigned*)(ws + WS_CTL) + CW_CNT + 64 * l; int* list = (int*)(ws + WS_LIST); v4u* route = (v4u*)(ws + WS_ROUTE);
    LAS float* part = (LAS float*)(lds + 8192); LAS float* dpart = (LAS float*)(lds + 9216); LAS float* scr = (LAS float*)(lds + 58368) + wave * 768;
    LAS v4u* rec = (LAS v4u*)(lds + 82944); LAS unsigned* lcnt = (LAS unsigned*)(lds + 82944 + 8192); LAS unsigned* lbase = lcnt + 32;
    if (tid < 32) lcnt[tid] = 0u;
    v4u wf[3][8];
    { const v4u* RW = (const v4u*)(ws + WS_RWR + l * RW_LSTRIDE);
#pragma unroll
      for (int n = 0; n < 3; ++n)
#pragma unroll
          for (int ks = 0; ks < 8; ++ks) wf[n][ks] = RW[(n * 64 + 8 * wave + ks) * 64 + lane]; }
    stage_gain(karg_in(I_N2G) + l * 2048, lds, tid);
    const LAS float* gl = (const LAS float*)lds + 256 * wave + 8 * quad;
    const int c0 = 256 * wave + 8 * quad;
    v4u xr[8];
    if (vcu < MTOK / 16) {
#pragma unroll
        for (int ks = 0; ks < 8; ++ks) xr[ks] = *(const GAS v4u*)(XB + ((size_t)vcu * 16 + row) * 2048 + c0 + 32 * ks); }
    int k = 0;
#pragma unroll 1
    for (int grp = vcu; grp < MTOK / 16; grp += G, ++k) {
        const size_t t = (size_t)grp * 16 + row; const int buf = k & 1;
        const bool more = grp + G < MTOK / 16;
        float zz = 0.f; asm volatile("" : "+v"(zz));
        f32x4 acc[3] = {{zz, zz, zz, zz}, {zz, zz, zz, zz}, {zz, zz, zz, zz}}; float ss = 0.f;
#pragma unroll
        for (int ks = 0; ks < 8; ++ks) {
            float x_[8]; unpack8(xr[ks], x_);
            const f32x4 ga = *(const LAS f32x4*)(gl + 32 * ks), gb = *(const LAS f32x4*)(gl + 32 * ks + 4); const float g8[8] = {ga.x, ga.y, ga.z, ga.w, gb.x, gb.y, gb.z, gb.w};
#pragma unroll
            for (int e = 0; e < 8; ++e) { ss += x_[e] * x_[e]; x_[e] *= g8[e]; }
            { v2u w8; w8.x = pk_fp8x4(x_[0], x_[1], x_[2], x_[3]); w8.y = pk_fp8x4(x_[4], x_[5], x_[6], x_[7]); *(GAS v2u*)(A8 + t * 2048 + c0 + 32 * ks) = w8; }
            v4u hi; hi.x = pk2(x_[0], x_[1]); hi.y = pk2(x_[2], x_[3]); hi.z = pk2(x_[4], x_[5]); hi.w = pk2(x_[6], x_[7]);
            v4u lo; lo.x = pk2(x_[0] - lo_f(hi.x), x_[1] - hi_f(hi.x)); lo.y = pk2(x_[2] - lo_f(hi.y), x_[3] - hi_f(hi.y)); lo.z = pk2(x_[4] - lo_f(hi.z), x_[5] - hi_f(hi.z)); lo.w = pk2(x_[6] - lo_f(hi.w), x_[7] - hi_f(hi.w));
            const bf16x8 ah = __builtin_bit_cast(bf16x8, hi), al = __builtin_bit_cast(bf16x8, lo);
#pragma unroll
            for (int n = 0; n < 3; ++n) { const bf16x8 bh = __builtin_bit_cast(bf16x8, wf[n][ks]); acc[n] = MFMA16(ah, bh, acc[n]); acc[n] = MFMA16(al, bh, acc[n]); }
            if (ks & 1) __builtin_amdgcn_sched_barrier(0);
        }
        if (more) {
#pragma unroll
            for (int ks = 0; ks < 8; ++ks) xr[ks] = *(const GAS v4u*)(XB + ((size_t)(grp + G) * 16 + row) * 2048 + c0 + 32 * ks); }
        { auto r16 = __builtin_amdgcn_permlane16_swap(__float_as_uint(ss), __float_as_uint(ss), false, false); ss = __uint_as_float(r16[0]) + __uint_as_float(r16[1]);
          auto r32 = __builtin_amdgcn_permlane32_swap(__float_as_uint(ss), __float_as_uint(ss), false, false); ss = __uint_as_float(r32[0]) + __uint_as_float(r32[1]); }
        if (quad == 0) part[(buf * 8 + wave) * 16 + row] = ss;
#pragma unroll
        for (int n = 0; n < 3; ++n) *(LAS f32x4*)(dpart + ((buf * 8 + wave) * 3 + n) * 256 + lane * 4) = acc[n];
        __syncthreads();
        if (wave == (k & 7)) {
            f32x4 d[3] = {{zz, zz, zz, zz}, {zz, zz, zz, zz}, {zz, zz, zz, zz}}; float sst = 0.f;
#pragma unroll 2
            for (int w8 = 0; w8 < 8; ++w8) { sst += part[(buf * 8 + w8) * 16 + row];
#pragma unroll
                for (int n = 0; n < 3; ++n) d[n] = d[n] + *(const LAS f32x4*)(dpart + ((buf * 8 + w8) * 3 + n) * 256 + lane * 4); }
            const float rstd = 1.0f / sqrtf(sst * (1.0f / 2048.0f) + EPS);
            if (quad == 0) RSTD[t] = rstd;
#pragma unroll
            for (int n = 0; n < 3; ++n)
#pragma unroll
                for (int j = 0; j < 4; ++j) scr[(quad * 4 + j) * 48 + n * 16 + row] = d[n][j];
            LDS_WAIT(); asm volatile("" ::: "memory");
            if (lane < 16) {
                const LAS float* L = scr + lane * 48;
                float lg[4];
#pragma unroll
                for (int c = 0; c < 4; ++c) lg[c] = L[c] * rstd + b_rg[c];
                int gi = 0; float gm = lg[0];
#pragma unroll
                for (int c = 1; c < 4; ++c) if (lg[c] > gm) { gm = lg[c]; gi = c; }
                float gs = 0.f;
#pragma unroll
                for (int c = 0; c < 4; ++c) gs += __expf(lg[c] - gm);
                const float pg = 1.0f / gs;
                float le[8];
#pragma unroll
                for (int j = 0; j < 8; ++j) le[j] = L[4 + gi * 8 + j] * rstd + b_re[gi * 8 + j];
                int i1 = 0; float v1 = le[0];
#pragma unroll
                for (int j = 1; j < 8; ++j) if (le[j] > v1) { v1 = le[j]; i1 = j; }
                int i2 = -1; float v2 = -INFINITY;
#pragma unroll
                for (int j = 0; j < 8; ++j) if (j != i1 && le[j] > v2) { v2 = le[j]; i2 = j; }
                const float dd = __expf(v2 - v1), wa = pg / (1.0f + dd), wb = pg * dd / (1.0f + dd);
                const int e1 = gi * 8 + i1, e2 = gi * 8 + i2;
                const unsigned l1 = __hip_atomic_fetch_add(lcnt + e1, 1u, __ATOMIC_RELAXED, __HIP_MEMORY_SCOPE_WORKGROUP), l2 = __hip_atomic_fetch_add(lcnt + e2, 1u, __ATOMIC_RELAXED, __HIP_MEMORY_SCOPE_WORKGROUP);
                v4u ro; ro.x = ((unsigned)e1 << 16) | l1; ro.y = ((unsigned)e2 << 16) | l2; ro.z = __float_as_uint(wa); ro.w = __float_as_uint(wb);
                rec[k * 16 + lane] = ro;
            }
        }
    }
    __syncthreads();
    if (tid < NEXP) { const unsigned n = lcnt[tid]; lbase[tid] = n ? __hip_atomic_fetch_add(cnt + tid, n, RLX_AGENT) : 0u; }
    __syncthreads();
    for (int ri = tid; ri < 16 * k; ri += 512) {
        const v4u ro = rec[ri]; const int grp = vcu + (ri >> 4) * G, t = grp * 16 + (ri & 15);
        const unsigned e1 = ro.x >> 16, e2 = ro.y >> 16, r1 = lbase[e1] + (ro.x & 0xffffu), r2 = lbase[e2] + (ro.y & 0xffffu);
        list[e1 * 32768 + r1] = t; list[e2 * 32768 + r2] = t;
        v4u o; o.x = (e1 << 16) | r1; o.y = (e2 << 16) | r2; o.z = ro.z; o.w = ro.w;
        route[t] = o;
    }
    __syncthreads();
}
__device__ __forceinline__ void final_phase(const Args& a, const LAS int* tp, int gw, int NGW, int lane) {
    unsigned char* ws = karg_ws(); const unsigned char* Y = ws + WS_Y; const v4u* route = (const v4u*)(ws + WS_ROUTE);
    v4u rnext = {0u, 0u, 0u, 0u}; if (gw < MTOK) rnext = route[gw];
    for (int t = gw; t < MTOK; t += NGW) {
        const v4u r = rnext; if (t + NGW < MTOK) rnext = route[t + NGW];
        const int s0 = tp[r.x >> 16] * 256 + (int)(r.x & 0xffffu), s1 = tp[r.y >> 16] * 256 + (int)(r.y & 0xffffu);
        float w0 = __uint_as_float(r.z), w1 = __uint_as_float(r.w);
        if (karg_flags() & 8) { w0 = 0.f; w1 = 0.f; }
        float* xo = karg_out() + (size_t)t * 2048 + lane * 8; const bf16* xi = (const bf16*)(ws + WS_XB) + (size_t)t * 2048 + lane * 8;
        const unsigned char* y0 = Y + (size_t)s0 * 2048 + lane * 8; const unsigned char* y1 = Y + (size_t)s1 * 2048 + lane * 8;
#pragma unroll
        for (int j = 0; j < 4; ++j) {
            const v4u xr = *(const GAS v4u*)(xi + j * 512);
            f32x4 xa = {lo_f(xr.x), hi_f(xr.x), lo_f(xr.y), hi_f(xr.y)}, xb = {lo_f(xr.z), hi_f(xr.z), lo_f(xr.w), hi_f(xr.w)};
            float p_[8], q_[8]; unpack_fp8x8(*(const GAS v2u*)(y0 + j * 512), p_); unpack_fp8x8(*(const GAS v2u*)(y1 + j * 512), q_);
            xa.x += w0 * p_[0] + w1 * q_[0]; xa.y += w0 * p_[1] + w1 * q_[1]; xa.z += w0 * p_[2] + w1 * q_[2]; xa.w += w0 * p_[3] + w1 * q_[3];
            xb.x += w0 * p_[4] + w1 * q_[4]; xb.y += w0 * p_[5] + w1 * q_[5]; xb.z += w0 * p_[6] + w1 * q_[6]; xb.w += w0 * p_[7] + w1 * q_[7];
#ifdef PROBE_EXPR
            { const float pv = (PROBE_EXPR); xa = xa + pv; xb = xb + pv; }
#endif
            *(GAS f32x4*)(xo + j * 512) = xa; *(GAS f32x4*)(xo + j * 512 + 4) = xb;
        }
    }
}

__device__ __forceinline__ void qkn_phase(const Args& a, int l, int gw, int NGW, int lane) {
    bf16* PROJ = (bf16*)(karg_ws() + WS_PROJ); const f32x4* rope = (const f32x4*)(karg_ws() + WS_ROPE);
    const float* qg = karg_in(I_QNG) + l * 64; const float* kg = karg_in(I_KNG) + l * 64;
    const int c8 = lane & 7;
    float gq[8], gk[8];
#pragma unroll
    for (int j = 0; j < 8; ++j) { gq[j] = qg[c8 * 8 + j] * QSCALE; gk[j] = kg[c8 * 8 + j]; }
    for (int grp = gw; grp < MTOK / 16; grp += NGW) {
#pragma unroll 1
        for (int it = 0; it < 4; ++it) {
            const int t0 = grp * 16 + it * 4;
            v4u raw[4][3];
#pragma unroll
            for (int k = 0; k < 4; ++k)
#pragma unroll
                for (int i = 0; i < 3; ++i) raw[k][i] = *(const GAS v4u*)(PROJ + (size_t)(t0 + k) * NPROJ + C_DAQ + (lane + 64 * i) * 8);
#pragma unroll
            for (int k = 0; k < 4; ++k) {
                const f32x4* rp = rope + (size_t)((t0 + k) & (SEQ - 1)) * 4;
                const f32x4 c0 = rp[0], c1 = rp[1], s0 = rp[2], s1 = rp[3];
                const float cs[8] = {c0.x, c0.y, c0.z, c0.w, c1.x, c1.y, c1.z, c1.w}, sn[8] = {s0.x, s0.y, s0.z, s0.w, s1.x, s1.y, s1.z, s1.w};
#pragma unroll
                for (int i = 0; i < 3; ++i) {
                    const bool isq = (lane + 64 * i) < 96;
                    float x[8]; unpack8(raw[k][i], x);
                    float ss = 0.f;
#pragma unroll
                    for (int j = 0; j < 8; ++j) ss += x[j] * x[j];
                    ss += sx(ss, 1); ss += sx(ss, 2); ss += sx(ss, 4);
                    const float rs = 1.0f / sqrtf(ss * (1.0f / 64.0f) + EPS);
#pragma unroll
                    for (int j = 0; j < 8; ++j) x[j] = x[j] * rs * (isq ? gq[j] : gk[j]);
                    float px[8];
#pragma unroll
                    for (int j = 0; j < 8; ++j) px[j] = sx(x[j], 1);
                    if (c8 == 0) {
#pragma unroll
                        for (int j = 0; j < 8; ++j) x[j] = x[j] * cs[j] - px[j] * sn[j];
                    } else if (c8 == 1) {
#pragma unroll
                        for (int j = 0; j < 8; ++j) x[j] = x[j] * cs[j] + px[j] * sn[j];
                    }
                    raw[k][i] = pack8(x);
                }
            }
#pragma unroll
            for (int k = 0; k < 4; ++k)
#pragma unroll
                for (int i = 0; i < 3; ++i) *(GAS v4u*)(PROJ + (size_t)(t0 + k) * NPROJ + C_DAQ + (lane + 64 * i) * 8) = raw[k][i];
        }
    }
}

struct MixP { const bf16* PROJ; bf16* MIX; const float* GATES; const float *vng, *gws, *gmb, *convw, *convb, *igb, *fgb, *mlng, *lamp, *subg; float lambda_init; };

__device__ __forceinline__ MixP make_mixp(const Args& args, int l_in) {
    int l = l_in; asm volatile("" : "+s"(l));
    unsigned char* ws = karg_ws(); MixP P;
    P.PROJ = (const bf16*)(ws + WS_PROJ); P.MIX = (bf16*)(ws + WS_BUFB); P.GATES = (const float*)(ws + WS_GATES);
    P.vng = karg_in(I_GMVG) + l * 512; P.gws = karg_in(I_GMWS) + l * 4 * 128 * 128; P.gmb = karg_in(I_GMB) + l * 512;
    P.convw = karg_in(I_CONVW) + l * 4 * 768; P.convb = karg_in(I_CONVB) + l * 768; P.igb = karg_in(I_IGB) + l * 6; P.fgb = karg_in(I_FGB) + l * 6; P.mlng = karg_in(I_MLNG) + l * 768;
    P.lamp = karg_in(I_LAM) + l * 256; P.subg = karg_in(I_SUBG) + l * 128; P.lambda_init = (l == 0) ? 0.2f : 0.35550906759096934f;
    return P;
}

__device__ __forceinline__ void gmlp_unit(int u, int l, const Args& args, LAS unsigned char* lds, int tid_in, int wave, int lane_in) {
    const MixP P = make_mixp(args, l);
    int tid = tid_in; asm volatile("" : "+v"(tid)); const int lane = tid & 63; (void)lane_in;
    const int g = u & 3, T0 = (u >> 2) * 128;
    LAS bf16* Vn = (LAS bf16*)lds;
    const int ti = wave >> 1, dj0 = (wave & 1) * 2, r = lane & 31, h = lane >> 5, q = (lane & 15) >> 2, p = lane & 3, nh = (lane >> 4) & 1;
    const int trow = 32 * ti + r;
    v4u vraw[4], uraw[4]; float bsv[4];
#pragma unroll
    for (int k = 0; k < 4; ++k) { const int id = tid + 512 * k, row = id >> 4, c16 = id & 15;
        vraw[k] = *(const GAS v4u*)(P.PROJ + (size_t)(T0 + row) * NPROJ + C_GMV + g * 128 + c16 * 8);
        uraw[k] = *(const GAS v4u*)(P.PROJ + (size_t)(T0 + row) * NPROJ + C_GMU + g * 128 + c16 * 8);
        bsv[k] = P.gmb[g * 128 + row]; }
    bf16x8 Af[8];
    { const float* Wrow = P.gws + ((size_t)g * 128 + trow) * 128;
#pragma unroll
      for (int ks = 0; ks < 8; ++ks) { const int s0 = 16 * ks + 8 * h;
          const f32x4 wa = *(const GAS f32x4*)(Wrow + s0), wb = *(const GAS f32x4*)(Wrow + s0 + 4);
          float w[8] = {wa.x, wa.y, wa.z, wa.w, wb.x, wb.y, wb.z, wb.w};
#pragma unroll
          for (int j = 0; j < 8; ++j) w[j] = (s0 + j <= trow) ? w[j] : 0.f;
          Af[ks] = __builtin_bit_cast(bf16x8, pack8(w)); } }
#pragma unroll
    for (int k = 0; k < 4; ++k) {
        const int id = tid + 512 * k, row = id >> 4, c16 = id & 15;
        float x[8]; unpack8(vraw[k], x);
        float ss = 0.f;
#pragma unroll
        for (int j = 0; j < 8; ++j) { x[j] = gelu_f(x[j]); ss += x[j] * x[j]; }
        ss += sx(ss, 1); ss += sx(ss, 2); ss += sx(ss, 4); ss += sx(ss, 8);
        const float rs = 1.0f / sqrtf(ss * (1.0f / 128.0f) + EPS);
        const float* vg = P.vng + g * 128 + c16 * 8;
#pragma unroll
        for (int j = 0; j < 8; ++j) x[j] = x[j] * rs * vg[j];
        *(LAS v4u*)(Vn + row * 136 + c16 * 8) = pack8(x);
    }
    __syncthreads();
    f32x16 acc0 = {}, acc1 = {};
#pragma unroll
    for (int ks = 0; ks < 8; ++ks) {
        if (ks < 2 * (ti + 1)) {
            const int s0 = 16 * ks + 8 * h;
            const LAS bf16* bp = Vn + (s0 + q) * 136 + 32 * dj0 + 16 * nh + 4 * p;
            const bf16x8 B0 = mk8(tr16(bp), tr16(bp + 4 * 136)), B1 = mk8(tr16(bp + 32), tr16(bp + 32 + 4 * 136));
            acc0 = MFMA32(Af[ks], B0, acc0); acc1 = MFMA32(Af[ks], B1, acc1);
        }
    }
    LAS float* Zs = (LAS float*)(lds + 36864);
#pragma unroll
    for (int rg = 0; rg < 16; ++rg) { const int t = 32 * ti + crow(rg, h); Zs[t * 132 + 32 * dj0 + r] = acc0[rg]; Zs[t * 132 + 32 * dj0 + 32 + r] = acc1[rg]; }
    __syncthreads();
#pragma unroll
    for (int k = 0; k < 4; ++k) {
        const int id = tid + 512 * k, row = id >> 4, c16 = id & 15;
        float uu[8]; unpack8(uraw[k], uu);
        const f32x4 za = *(const LAS f32x4*)(Zs + row * 132 + c16 * 8), zb = *(const LAS f32x4*)(Zs + row * 132 + c16 * 8 + 4);
        const float z[8] = {za.x, za.y, za.z, za.w, zb.x, zb.y, zb.z, zb.w};
#pragma unroll
        for (int j = 0; j < 8; ++j) uu[j] = gelu_f(uu[j]) * (z[j] + bsv[k]);
        *(GAS v4u*)(P.MIX + (size_t)(T0 + row) * 2048 + g * 128 + c16 * 8) = pack8(uu);
    }
    __syncthreads();
}

__device__ __forceinline__ void mlstm_unit(int u, int l, const Args& args, LAS unsigned char* lds, int tid_in, int wave, int lane_in) {
    const MixP P = make_mixp(args, l);
    int tid = tid_in; asm volatile("" : "+v"(tid)); const int lane = tid & 63; (void)lane_in;
    const int b = u / 6, hd = u % 6; const size_t rowbase = (size_t)b * SEQ;
    LAS bf16* Qs = (LAS bf16*)lds;
    LAS bf16* Ks = (LAS bf16*)(lds + 18432);
    LAS bf16* Hs = (LAS bf16*)lds;
    LAS float* npart = (LAS float*)(lds + 36864);
    LAS bf16* Vs = (LAS bf16*)(lds + 55296);
    LAS bf16* Ct = (LAS bf16*)(lds + 90112);
    LAS float* beta = (LAS float*)(lds + 108544); LAS float* alpha = beta + 128; LAS float* winter = beta + 256; LAS float* thr = beta + 384; LAS float* wupd = beta + 512;
    LAS float* nst = beta + 640; LAS float* scal = beta + 704;
    const int r = lane & 31, h = lane >> 5, q = (lane & 15) >> 2, p = lane & 3, nh = (lane >> 4) & 1;
    f32x16 Cacc = {};
    for (int i = tid; i < 128 * 72 / 2; i += 512) ((LAS unsigned*)Ct)[i] = 0u;
    if (tid < 64) nst[tid] = 0.f;
    float m_st = 0.f;
    const float igb = P.igb[hd], fgb = P.fgb[hd];
    LAS float* g_be = (LAS float*)(lds + 114688); LAS float* g_b = g_be + 2048; LAS float* g_cm = g_be + 4096;
    LAS float* ngl = g_be + 6144;
    if (tid < 128) ngl[tid] = P.mlng[hd * 128 + tid];
    LAS float* cwl = ngl + 128; LAS float* cbl = cwl + 512;
    cwl[tid] = P.convw[(tid >> 7) * 768 + ((tid >> 6) & 1) * 384 + hd * 64 + (tid & 63)];
    if (tid < 128) cbl[tid] = P.convb[(tid >> 6) * 384 + hd * 64 + (tid & 63)];
#pragma unroll 1
    for (int cc = wave; cc < 16; cc += 8) {
        const size_t Tg = rowbase + (size_t)cc * 128; const int i0 = 2 * lane;
        const float ig0 = P.GATES[(Tg + i0) * 16 + hd] + igb, ig1 = P.GATES[(Tg + i0 + 1) * 16 + hd] + igb;
        const float f0 = P.GATES[(Tg + i0) * 16 + 6 + hd] + fgb, f1 = P.GATES[(Tg + i0 + 1) * 16 + 6 + hd] + fgb;
        const float lf0 = fminf(f0, 0.f) - log1pf(__expf(-fabsf(f0))), lf1 = fminf(f1, 0.f) - log1pf(__expf(-fabsf(f1)));
        float sc = lf0 + lf1;
#pragma unroll
        for (int o = 1; o < 64; o <<= 1) { const float tt = sup(sc, o); if (lane >= o) sc += tt; }
        const float b1 = sc, b0 = sc - lf1;
        const float be0 = ig0 - b0, be1 = ig1 - b1;
        float mx = fmaxf(be0, be1);
#pragma unroll
        for (int o = 1; o < 64; o <<= 1) { const float tt = sup(mx, o); if (lane >= o) mx = fmaxf(mx, tt); }
        float prev = sup(mx, 1); if (lane == 0) prev = -INFINITY;
        const float cm0 = fmaxf(prev, be0), cm1 = mx;
        g_be[cc * 128 + i0] = be0; g_be[cc * 128 + i0 + 1] = be1; g_b[cc * 128 + i0] = b0; g_b[cc * 128 + i0 + 1] = b1; g_cm[cc * 128 + i0] = cm0; g_cm[cc * 128 + i0 + 1] = cm1;
    }
    __syncthreads();
#pragma unroll 1
    for (int c = 0; c < 16; ++c) {
        const size_t T0 = rowbase + (size_t)c * 128;
        if (tid < 128) {
            const float be = g_be[c * 128 + tid], bb = g_b[c * 128 + tid], cm = g_cm[c * 128 + tid], cm_end = g_cm[c * 128 + 127], b_end = g_b[c * 128 + 127];
            const float al = -fmaxf(m_st, cm), a_end = -fmaxf(m_st, cm_end);
            beta[tid] = be; alpha[tid] = al; winter[tid] = __expf(m_st + al); thr[tid] = __expf(al - bb); wupd[tid] = __expf(be + a_end);
            if (tid == 0) { scal[0] = __expf(m_st + a_end); scal[1] = b_end - a_end; }
        }
        v4u vraw[4], xt[2][2][4];
#pragma unroll
        for (int k = 0; k < 4; ++k) { const int id = tid + 512 * k, row = id >> 4, c16 = id & 15; vraw[k] = *(const GAS v4u*)(P.PROJ + (T0 + row) * NPROJ + C_MLV + hd * 128 + c16 * 8); }
#define ML_TAPS(qk_, k_) do { const int id = tid + 512 * (k_), row = id >> 3, c8 = id & 7; \
            const bf16* src = P.PROJ + (T0 + row) * NPROJ + ((qk_) ? C_MLK : C_MLQ) + hd * 64 + c8 * 8; \
            _Pragma("unroll") for (int j = 0; j < 4; ++j) { const int srow = c * 128 + row - 3 + j; xt[qk_][k_][j] = *(const GAS v4u*)(src + (long)((srow >= 0) ? (j - 3) : 0) * NPROJ); } } while (0)
        ML_TAPS(0, 0); ML_TAPS(0, 1); ML_TAPS(1, 0); ML_TAPS(1, 1);
#pragma unroll
        for (int k = 0; k < 4; ++k) { const int id = tid + 512 * k, row = id >> 4, c16 = id & 15; *(LAS v4u*)(Vs + row * 136 + c16 * 8) = vraw[k]; }
#undef ML_TAPS
#pragma unroll
        for (int qk = 0; qk < 2; ++qk) {
#pragma unroll
            for (int k = 0; k < 2; ++k) {
                const int id = tid + 512 * k, row = id >> 3; int c8 = id & 7; asm volatile("" : "+v"(c8));
                float y[8];
                { const f32x4 ba = *(const LAS f32x4*)(cbl + qk * 64 + c8 * 8), bb = *(const LAS f32x4*)(cbl + qk * 64 + c8 * 8 + 4); y[0] = ba.x; y[1] = ba.y; y[2] = ba.z; y[3] = ba.w; y[4] = bb.x; y[5] = bb.y; y[6] = bb.z; y[7] = bb.w; }
#pragma unroll
                for (int j = 0; j < 4; ++j) {
                    const int srow = c * 128 + row - 3 + j; const float msk = (srow >= 0) ? 1.0f : 0.0f;
                    float x[8]; unpack8(xt[qk][k][j], x);
                    const f32x4 wa = *(const LAS f32x4*)(cwl + (j * 2 + qk) * 64 + c8 * 8) * msk, wb = *(const LAS f32x4*)(cwl + (j * 2 + qk) * 64 + c8 * 8 + 4) * msk;
                    y[0] += wa.x * x[0]; y[1] += wa.y * x[1]; y[2] += wa.z * x[2]; y[3] += wa.w * x[3]; y[4] += wb.x * x[4]; y[5] += wb.y * x[5]; y[6] += wb.z * x[6]; y[7] += wb.w * x[7];
                }
                if (qk == 0) {
#pragma unroll
                    for (int jj = 0; jj < 8; ++jj) y[jj] = silu_f(y[jj]);
                    *(LAS v4u*)(Qs + row * 72 + c8 * 8) = pack8(y);
                } else {
#pragma unroll
                    for (int jj = 0; jj < 8; ++jj) y[jj] = silu_f(y[jj]) * 0.125f;
                    *(LAS v4u*)(Ks + row * 72 + c8 * 8) = pack8(y);
                }
            }
        }
        __syncthreads();
        const int ib = wave >> 1, dvh = wave & 1, iabs = 32 * ib + r;
        const float al_i = alpha[iabs], wi_i = winter[iabs], th_i = thr[iabs];
        bf16x8 Bq[4];
#pragma unroll
        for (int ks = 0; ks < 4; ++ks) Bq[ks] = *(const LAS bf16x8*)(Qs + iabs * 72 + 16 * ks + 8 * h);
        f32x16 num0 = {}, num1 = {}; float den = 0.f;
        for (int sb = 0; sb <= ib; ++sb) {
            f32x16 X = {};
#pragma unroll
            for (int ks = 0; ks < 4; ++ks) { const bf16x8 Ak = *(const LAS bf16x8*)(Ks + (32 * sb + r) * 72 + 16 * ks + 8 * h); X = MFMA32(Ak, Bq[ks], X); }
#pragma unroll
            for (int rg = 0; rg < 16; ++rg) { const int sabs = 32 * sb + crow(rg, h); const float w = (sabs <= iabs) ? __expf(al_i + beta[sabs]) : 0.f; X[rg] *= w; den += X[rg]; }
#pragma unroll
            for (int st = 0; st < 2; ++st) {
                v4u pw; pw.x = pk2(X[8 * st], X[8 * st + 1]); pw.y = pk2(X[8 * st + 2], X[8 * st + 3]); pw.z = pk2(X[8 * st + 4], X[8 * st + 5]); pw.w = pk2(X[8 * st + 6], X[8 * st + 7]);
                const bf16x8 Bs = __builtin_bit_cast(bf16x8, pw);
                const LAS bf16* vp = Vs + (32 * sb + 16 * st + 4 * h + q) * 136 + 64 * dvh + 16 * nh + 4 * p;
                const bf16x8 A0 = mk8(tr16(vp), tr16(vp + 8 * 136)), A1 = mk8(tr16(vp + 32), tr16(vp + 32 + 8 * 136));
                num0 = MFMA32(A0, Bs, num0); num1 = MFMA32(A1, Bs, num1);
            }
        }
        f32x16 in0 = {}, in1 = {};
#pragma unroll
        for (int ks = 0; ks < 4; ++ks) {
            const bf16x8 A0 = *(const LAS bf16x8*)(Ct + (64 * dvh + r) * 72 + 16 * ks + 8 * h), A1 = *(const LAS bf16x8*)(Ct + (64 * dvh + 32 + r) * 72 + 16 * ks + 8 * h);
            in0 = MFMA32(A0, Bq[ks], in0); in1 = MFMA32(A1, Bq[ks], in1);
        }
        float qn = 0.f;
#pragma unroll
        for (int k4 = 0; k4 < 4; ++k4) { float x[8]; unpack8(*(const LAS v4u*)(Qs + iabs * 72 + 32 * h + 8 * k4), x);
#pragma unroll
            for (int j = 0; j < 8; ++j) qn += x[j] * nst[32 * h + 8 * k4 + j]; }
        qn += sx(qn, 32); den += sx(den, 32);
        const float dtot = den + wi_i * qn, hsc = 1.0f / fmaxf(fabsf(dtot), th_i);
#pragma unroll
        for (int rg = 0; rg < 16; ++rg) { num0[rg] = (num0[rg] + wi_i * in0[rg]) * hsc; num1[rg] = (num1[rg] + wi_i * in1[rg]) * hsc; }
        const int dvt = wave >> 1, dkt = wave & 1; const float decay = scal[0], m_new = scal[1];
#pragma unroll
        for (int rg = 0; rg < 16; ++rg) Cacc[rg] *= decay;
#pragma unroll
        for (int ks = 0; ks < 8; ++ks) {
            const LAS bf16* vp = Vs + (16 * ks + 8 * h + q) * 136 + 32 * dvt + 16 * nh + 4 * p;
            const LAS bf16* kp = Ks + (16 * ks + 8 * h + q) * 72 + 32 * dkt + 16 * nh + 4 * p;
            const s16x4 va = tr16(vp), vb = tr16(vp + 4 * 136);
            const f32x4 wa = *(const LAS f32x4*)(wupd + 16 * ks + 8 * h), wb = *(const LAS f32x4*)(wupd + 16 * ks + 8 * h + 4);
            v4u aw; aw.x = pk2(bf2f((unsigned short)va[0]) * wa.x, bf2f((unsigned short)va[1]) * wa.y); aw.y = pk2(bf2f((unsigned short)va[2]) * wa.z, bf2f((unsigned short)va[3]) * wa.w);
            aw.z = pk2(bf2f((unsigned short)vb[0]) * wb.x, bf2f((unsigned short)vb[1]) * wb.y); aw.w = pk2(bf2f((unsigned short)vb[2]) * wb.z, bf2f((unsigned short)vb[3]) * wb.w);
            const bf16x8 Av = __builtin_bit_cast(bf16x8, aw), Bk = mk8(tr16(kp), tr16(kp + 4 * 72));
            Cacc = MFMA32(Av, Bk, Cacc);
        }
        { float ps = 0.f;
#pragma unroll
            for (int s8 = 0; s8 < 16; ++s8) ps += wupd[16 * wave + s8] * bf2f(Ks[(16 * wave + s8) * 72 + lane]);
            npart[wave * 64 + lane] = ps; }
        v4u ogate[4];
        { const bf16* op = P.PROJ + (T0 + (tid >> 2)) * NPROJ + C_MLO + hd * 128 + (tid & 3) * 32;
#pragma unroll
            for (int k = 0; k < 4; ++k) ogate[k] = *(const GAS v4u*)(op + k * 8); }
        __syncthreads();
#pragma unroll
        for (int g4 = 0; g4 < 4; ++g4) {
            v2u w0; w0.x = pk2(num0[4 * g4], num0[4 * g4 + 1]); w0.y = pk2(num0[4 * g4 + 2], num0[4 * g4 + 3]);
            v2u w1; w1.x = pk2(num1[4 * g4], num1[4 * g4 + 1]); w1.y = pk2(num1[4 * g4 + 2], num1[4 * g4 + 3]);
            *(LAS v2u*)(Hs + iabs * 136 + 64 * dvh + 8 * g4 + 4 * h) = w0; *(LAS v2u*)(Hs + iabs * 136 + 64 * dvh + 32 + 8 * g4 + 4 * h) = w1;
        }
#pragma unroll
        for (int rg = 0; rg < 16; ++rg) Ct[(32 * dvt + crow(rg, h)) * 72 + 32 * dkt + r] = (bf16)f2bf(Cacc[rg]);
        if (tid < 64) { float s = 0.f;
#pragma unroll
            for (int w8 = 0; w8 < 8; ++w8) s += npart[w8 * 64 + tid];
            nst[tid] = decay * nst[tid] + s; }
        m_st = m_new;
        __syncthreads();
        {
            const int row = tid >> 2, part = tid & 3; float v[32];
#pragma unroll
            for (int k = 0; k < 4; ++k) { float x[8]; unpack8(*(const LAS v4u*)(Hs + row * 136 + part * 32 + k * 8), x);
#pragma unroll
                for (int j = 0; j < 8; ++j) v[k * 8 + j] = x[j]; }
            float ss = 0.f;
#pragma unroll
            for (int j = 0; j < 32; ++j) ss += v[j] * v[j];
            ss += sx(ss, 1); ss += sx(ss, 2);
            const float rs = 1.0f / sqrtf(ss * (1.0f / 128.0f) + EPS);
            const LAS float* ng = ngl + part * 32;
            bf16* mp = P.MIX + (T0 + row) * 2048 + 512 + hd * 128 + part * 32;
#pragma unroll
            for (int k = 0; k < 4; ++k) { float o[8], y[8]; unpack8(ogate[k], o);
#pragma unroll
                for (int j = 0; j < 8; ++j) y[j] = v[k * 8 + j] * rs * ng[k * 8 + j] * sigmoid_f(o[j]);
                *(GAS v4u*)(mp + k * 8) = pack8(y); }
        }
        __syncthreads();
    }
}

__device__ __forceinline__ void dattn_unit(int u, int l, const Args& args, unsigned char* shm, int wave, int lane_in) {
    const MixP P = make_mixp(args, l);
    int lane = lane_in; asm volatile("" : "+v"(lane));
    const int qb = 7 - u / 96, bh = u % 96, b = bh / 6, hd = bh % 6;
    const size_t rowbase = (size_t)b * SEQ; const int q0 = qb * 256;
    const float la = P.lamp[lane] * P.lamp[64 + lane], lb = P.lamp[128 + lane] * P.lamp[192 + lane];
    const float lam = __builtin_bit_cast(float, __builtin_amdgcn_readfirstlane(__builtin_bit_cast(int, __expf(wave_sum(la)) - __expf(wave_sum(lb)) + P.lambda_init)));
    typedef attn_body::bf16 abf;
#pragma unroll 1
    for (int run = 0; run < 4; ++run) {
        const int m = __builtin_amdgcn_readfirstlane(run >> 1), f = __builtin_amdgcn_readfirstlane(run & 1);
        const abf* Qw0 = (const abf*)P.PROJ + (rowbase + q0) * NPROJ + C_DAQ + (hd * 2 + m) * 64;
        const abf* Kh = (const abf*)P.PROJ + rowbase * NPROJ + C_DAK + (hd * 2 + m) * 64;
        const abf* Vh = (const abf*)P.PROJ + rowbase * NPROJ + C_DAV + hd * 128 + f * 64;
        attn_body::attn_run<8>(Qw0, Kh, Vh, q0, (char*)shm, m, f * 64, lam, wave);
    }
    const LAS bf16* hold = (const LAS bf16*)((LAS unsigned char*)shm + attn_body::LDS_HOLD) + wave * 4096;
    const int row = lane >> 1, half = lane & 1;
    float ss = 0.f;
#pragma unroll
    for (int k = 0; k < 8; ++k) { float x[8]; unpack8(*(const LAS v4u*)(hold + row * 128 + half * 64 + k * 8), x);
#pragma unroll
        for (int j = 0; j < 8; ++j) ss += x[j] * x[j]; }
    ss += sx(ss, 1);
    const float sc = (1.0f - P.lambda_init) / sqrtf(ss * (1.0f / 128.0f) + EPS);
    bf16* mp = P.MIX + (rowbase + q0 + wave * 32 + row) * 2048 + 1280 + hd * 128 + half * 64; const float* sg = P.subg + half * 64;
#pragma unroll
    for (int k = 0; k < 8; ++k) { float x[8]; unpack8(*(const LAS v4u*)(hold + row * 128 + half * 64 + k * 8), x);
#pragma unroll
        for (int j = 0; j < 8; ++j) x[j] = x[j] * sc * sg[k * 8 + j];
        *(GAS v4u*)(mp + k * 8) = pack8(x); }
    LDS_WAIT();
    __syncthreads();
}

namespace da2 {
constexpr int STAGE = 32768, NST = 4;
__device__ __forceinline__ void glds16(const void* gsrc, unsigned lds_dst) { unsigned keep;
    asm volatile("s_mov_b32 %0, m0\n\ts_mov_b32 m0, %2\n\ts_nop 0\n\tglobal_load_lds_dwordx4 %1, off\n\ts_mov_b32 m0, %0" : "=&s"(keep) : "v"(gsrc), "s"(lds_dst) : "memory"); }
#define DA2_WAIT_BAR(N) asm volatile("s_waitcnt vmcnt(" #N ") lgkmcnt(0)\n\ts_barrier" ::: "memory")
__device__ __forceinline__ float swap_max(float v) { auto rr = __builtin_amdgcn_permlane32_swap(__float_as_uint(v), __float_as_uint(v), false, false); return fmaxf(__uint_as_float(rr[0]), __uint_as_float(rr[1])); }
__device__ __forceinline__ float swap_add(float v) { auto rr = __builtin_amdgcn_permlane32_swap(__float_as_uint(v), __float_as_uint(v), false, false); return __uint_as_float(rr[0]) + __uint_as_float(rr[1]); }
__device__ __forceinline__ float max3f(float a, float b, float c) { float r; asm("v_max3_f32 %0, %1, %2, %3" : "=v"(r) : "v"(a), "v"(b), "v"(c)); return r; }
__device__ __forceinline__ float max16(const f32x16& c) { float r;
    asm("v_max3_f32 %0, %1, %2, %3\n\tv_max3_f32 %0, %0, %4, %5\n\tv_max3_f32 %0, %0, %6, %7\n\tv_max3_f32 %0, %0, %8, %9\n\tv_max3_f32 %0, %0, %10, %11\n\tv_max3_f32 %0, %0, %12, %13\n\tv_max3_f32 %0, %0, %14, %15\n\tv_max3_f32 %0, %0, %16, %16"
        : "=&v"(r) : "v"(c[0]), "v"(c[1]), "v"(c[2]), "v"(c[3]), "v"(c[4]), "v"(c[5]), "v"(c[6]), "v"(c[7]), "v"(c[8]), "v"(c[9]), "v"(c[10]), "v"(c[11]), "v"(c[12]), "v"(c[13]), "v"(c[14]), "v"(c[15]));
    return r; }

__device__ __forceinline__ void unit(int u, const MixP& P, LAS unsigned char* lds, int wave, int lane_in) {
    int lane = lane_in; asm volatile("" : "+v"(lane));
    const int pfl = PROBE_REP >= 0 ? karg_flags() : 0;
    const int qi = 15 - u / 96, bh = u % 96, b = bh / 6, hd = bh % 6;
    const size_t T0 = (size_t)b * SEQ; const int q0 = qi * 128, NT = (pfl & 16384) ? 2 : 2 * (qi + 1);
    const int map = wave >> 2, wq = wave & 3, r32 = lane & 31, hi = lane >> 5, q4 = (lane & 15) >> 2, p4 = lane & 3, nh = (lane >> 4) & 1;
    const unsigned lds0 = (unsigned)(unsigned long long)lds;
    const float lam = *(const LAS float*)(lds + MISC_OFF + 24);
    const int krow = 8 * wave + (lane >> 3), kx7 = (krow >> 1) & 7, kx1 = (krow >> 1) & 1;
    const bf16* ksrc0 = P.PROJ + (T0 + krow) * NPROJ + C_DAK + hd * 128 + 8 * ((lane & 7) ^ kx7), *ksrc1 = ksrc0 + 64;
    const bf16* vsrc0 = P.PROJ + (T0 + krow) * NPROJ + C_DAV + hd * 128 + 32 * (((lane & 7) >> 2) ^ kx1) + 8 * (lane & 3), *vsrc1 = vsrc0 + 64;
    const unsigned kd0 = lds0 + wave * 1024, kd1 = kd0 + 8192, vd0 = lds0 + 16384 + wave * 1024, vd1 = vd0 + 8192;
#define DA2_DMA(t_, st_) do { const size_t go_ = (size_t)(t_) * 64 * NPROJ; const unsigned so_ = (unsigned)(st_) * STAGE; \
        glds16(ksrc0 + go_, (unsigned)__builtin_amdgcn_readfirstlane(kd0 + so_)); glds16(ksrc1 + go_, (unsigned)__builtin_amdgcn_readfirstlane(kd1 + so_)); \
        glds16(vsrc0 + go_, (unsigned)__builtin_amdgcn_readfirstlane(vd0 + so_)); glds16(vsrc1 + go_, (unsigned)__builtin_amdgcn_readfirstlane(vd1 + so_)); } while (0)
    bf16x8 qr[4];
    { const bf16* qp = P.PROJ + (T0 + q0 + wq * 32 + r32) * NPROJ + C_DAQ + (hd * 2 + map) * 64 + 8 * hi;
#pragma unroll
      for (int ds = 0; ds < 4; ++ds) qr[ds] = *(const GAS bf16x8*)(qp + 16 * ds); }
    DA2_DMA(0, 0); DA2_DMA(1, 1); if (NT > 2) DA2_DMA(2, 2);
    f32x16 o0 = {}, o1 = {}, o2 = {}, o3 = {};
    const int qabs = q0 + wq * 32 + r32, qmin = q0 + wq * 32;
    const LAS unsigned char* kfb = lds + map * 8192 + r32 * 128;
    int kof[4];
#pragma unroll
    for (int ds = 0; ds < 4; ++ds) kof[ds] = ((2 * ds + hi) ^ ((r32 >> 1) & 7)) * 16;
    const int vxa = ((q4 >> 1) & 1) * 64, vxb = 64 - vxa;
    const LAS unsigned char* vfb = lds + 16384 + (4 * hi + q4) * 128 + 32 * nh + 8 * p4;
#define DA2_QK(P0_, P1_, C_, stg_) do { const LAS unsigned char* kf_ = kfb + (stg_) * STAGE; bf16x8 ka_[4], kb_[4]; \
        _Pragma("unroll") for (int ds = 0; ds < 4; ++ds) ka_[ds] = *(const LAS bf16x8*)(kf_ + kof[ds]); \
        _Pragma("unroll") for (int ds = 0; ds < 4; ++ds) kb_[ds] = *(const LAS bf16x8*)(kf_ + kof[ds] + 4096); \
        P0_ = MFMA32(ka_[0], qr[0], C_); P1_ = MFMA32(kb_[0], qr[0], C_); \
        _Pragma("unroll") for (int ds = 1; ds < 4; ++ds) { P0_ = MFMA32(ka_[ds], qr[ds], P0_); P1_ = MFMA32(kb_[ds], qr[ds], P1_); } \
        __builtin_amdgcn_sched_group_barrier(0x100, 8, 0); __builtin_amdgcn_sched_group_barrier(0x008, 8, 0); } while (0)
#define DA2_SPLAT(P_, v_) do { _Pragma("unroll") for (int rg = 0; rg < 16; ++rg) P_[rg] = (v_); } while (0)
    if (NT > 2) DA2_WAIT_BAR(8); else DA2_WAIT_BAR(4);
    float m_run = 0.f, l_run = 0.f; float ninf = -INFINITY; asm volatile("" : "+v"(ninf));
    f32x16 negm = {}, sa0, sa1, sb0, sb1; DA2_QK(sa0, sa1, negm, 0);
    if (map == 1) __builtin_amdgcn_s_setprio(1);
    int st = 0;
#define DA2_STEP(t_, C0_, C1_, N0_, N1_) do { const int tt_ = (t_); \
        const int st1 = (st == 3) ? 0 : st + 1; \
        if (tt_ + 2 < NT) DA2_WAIT_BAR(4); else DA2_WAIT_BAR(0);                     \
        if (tt_ + 3 < NT) { const int s3 = (st == 0) ? 3 : st - 1; DA2_DMA(tt_ + 3, s3); }     \
        if (!(pfl & 8192)) DA2_QK(N0_, N1_, negm, st1);                                    \
        if (64 * tt_ <= qmin + 31) {                                                 \
            const LAS unsigned char* vf = vfb + st * STAGE; \
            if (64 * tt_ + 63 > qmin) {                                              \
                _Pragma("unroll") for (int rg = 0; rg < 16; ++rg) { const int ka = 64 * tt_ + crow(rg, hi); if (ka > qabs) C0_[rg] = ninf; if (ka + 32 > qabs) C1_[rg] = ninf; } \
            } \
            if (!(pfl & 2048)) { \
            const float mxa_ = max16(C0_), mxb_ = max16(C1_); \
            const float mx = swap_max(max3f(mxa_, mxb_, mxb_)); \
            if (tt_ == 0 || __any(mx > 6.0f)) {                                      \
                const float d_ = (tt_ == 0) ? mx : fmaxf(mx, 0.f); const float al = (tt_ == 0) ? 1.f : __builtin_amdgcn_exp2f(-d_); l_run *= al; m_run += d_; \
                _Pragma("unroll") for (int rg = 0; rg < 16; ++rg) { o0[rg] *= al; o1[rg] *= al; o2[rg] *= al; o3[rg] *= al; C0_[rg] -= d_; C1_[rg] -= d_; N0_[rg] -= d_; N1_[rg] -= d_; } \
                DA2_SPLAT(negm, -m_run); } \
            float rs = 0.f; \
            _Pragma("unroll") for (int rg = 0; rg < 16; ++rg) { C0_[rg] = __builtin_amdgcn_exp2f(C0_[rg]); rs += C0_[rg]; C1_[rg] = __builtin_amdgcn_exp2f(C1_[rg]); rs += C1_[rg]; } \
            l_run += rs; \
            } \
            bf16x8 pf[4]; \
            { v4u w; w.x = pk2(C0_[0], C0_[1]); w.y = pk2(C0_[2], C0_[3]); w.z = pk2(C0_[4], C0_[5]); w.w = pk2(C0_[6], C0_[7]); pf[0] = __builtin_bit_cast(bf16x8, w); \
              w.x = pk2(C0_[8], C0_[9]); w.y = pk2(C0_[10], C0_[11]); w.z = pk2(C0_[12], C0_[13]); w.w = pk2(C0_[14], C0_[15]); pf[1] = __builtin_bit_cast(bf16x8, w); \
              w.x = pk2(C1_[0], C1_[1]); w.y = pk2(C1_[2], C1_[3]); w.z = pk2(C1_[4], C1_[5]); w.w = pk2(C1_[6], C1_[7]); pf[2] = __builtin_bit_cast(bf16x8, w); \
              w.x = pk2(C1_[8], C1_[9]); w.y = pk2(C1_[10], C1_[11]); w.z = pk2(C1_[12], C1_[13]); w.w = pk2(C1_[14], C1_[15]); pf[3] = __builtin_bit_cast(bf16x8, w); } \
            if (!(pfl & 4096)) \
            _Pragma("unroll") for (int s = 0; s < 4; ++s) { \
                const LAS bf16* va_ = (const LAS bf16*)(vf + s * 2048 + vxa); const LAS bf16* vb_ = (const LAS bf16*)(vf + s * 2048 + vxb); \
                const bf16x8 a0 = mk8(tr16(va_), tr16(va_ + 512)), a1 = mk8(tr16(vb_), tr16(vb_ + 512)), a2 = mk8(tr16(va_ + 4096), tr16(va_ + 4096 + 512)), a3 = mk8(tr16(vb_ + 4096), tr16(vb_ + 4096 + 512)); \
                o0 = MFMA32(a0, pf[s], o0); o1 = MFMA32(a1, pf[s], o1); o2 = MFMA32(a2, pf[s], o2); o3 = MFMA32(a3, pf[s], o3); \
            } \
        } \
        st = st1; } while (0)
#pragma unroll 1
    for (int t = 0; t < NT; t += 2) {
        DA2_STEP(t, sa0, sa1, sb0, sb1);
        DA2_STEP(t + 1, sb0, sb1, sa0, sa1);
    }
#undef DA2_STEP
#undef DA2_SPLAT
#undef DA2_QK
    __builtin_amdgcn_s_setprio(0);
    unsigned pre_ = 0u; const bool t0_ = (wave == 0) && (lane == 0);
    if (t0_) { unsigned* hp_ = (unsigned*)*(const LAS unsigned long long*)(lds + MISC_OFF + 32); pre_ = __hip_atomic_fetch_add(hp_, 1u, RLX_AGENT); }
    f32x4 sg[4][4];
    if (map == 0) {
#pragma unroll
        for (int g = 0; g < 4; ++g)
#pragma unroll
            for (int j = 0; j < 4; ++j) sg[g][j] = *(const GAS f32x4*)(P.subg + 32 * j + 8 * g + 4 * hi);
    }
#define DA2_LBAR() asm volatile("s_waitcnt lgkmcnt(0)\n\ts_barrier" ::: "memory")
    { const float inv = 1.0f / swap_add(l_run);
#pragma unroll
      for (int rg = 0; rg < 16; ++rg) { o0[rg] *= inv; o1[rg] *= inv; o2[rg] *= inv; o3[rg] *= inv; } }
    DA2_LBAR();
    LAS float* xb = (LAS float*)lds + wq * 4096 + lane;
    if (map == 1) {
#pragma unroll
        for (int rg = 0; rg < 16; ++rg) { xb[rg * 64] = o0[rg]; xb[(16 + rg) * 64] = o1[rg]; xb[(32 + rg) * 64] = o2[rg]; xb[(48 + rg) * 64] = o3[rg]; }
    }
    DA2_LBAR();
    if (map == 0) {
        float ss = 0.f;
#pragma unroll
        for (int rg = 0; rg < 16; ++rg) { o0[rg] -= lam * xb[rg * 64]; o1[rg] -= lam * xb[(16 + rg) * 64]; o2[rg] -= lam * xb[(32 + rg) * 64]; o3[rg] -= lam * xb[(48 + rg) * 64];
            ss += o0[rg] * o0[rg] + o1[rg] * o1[rg] + o2[rg] * o2[rg] + o3[rg] * o3[rg]; }
        ss = swap_add(ss);
        const float sc = (1.0f - P.lambda_init) / sqrtf(ss * (1.0f / 128.0f) + EPS);
        bf16* mp = P.MIX + (T0 + qabs) * 2048 + 1280 + hd * 128 + 8 * hi;
#define DA2_PK(o_, g_, s_) (v2u){pk2(o_[4 * (g_)] * sc * s_.x, o_[4 * (g_) + 1] * sc * s_.y), pk2(o_[4 * (g_) + 2] * sc * s_.z, o_[4 * (g_) + 3] * sc * s_.w)}
#define DA2_ST16(o_, j_, g_) do { v2u a_ = DA2_PK(o_, g_, sg[g_][j_]), b_ = DA2_PK(o_, (g_) + 1, sg[(g_) + 1][j_]); \
            auto rx_ = __builtin_amdgcn_permlane32_swap(a_.x, b_.x, false, false); auto ry_ = __builtin_amdgcn_permlane32_swap(a_.y, b_.y, false, false); \
            v4u w_; w_.x = rx_[0]; w_.y = ry_[0]; w_.z = rx_[1]; w_.w = ry_[1]; *(GAS v4u*)(mp + 32 * (j_) + 8 * (g_)) = w_; } while (0)
#pragma unroll
        for (int g = 0; g < 4; g += 2) { DA2_ST16(o0, 0, g); DA2_ST16(o1, 1, g); DA2_ST16(o2, 2, g); DA2_ST16(o3, 3, g); }
#undef DA2_ST16
#undef DA2_PK
    }
    if (t0_) *(volatile LAS unsigned*)(lds + MISC_OFF + 28) = pre_ + 1u;
    DA2_LBAR();
#undef DA2_DMA
#undef DA2_LBAR
}
#undef DA2_WAIT_BAR
}

constexpr int NPHASE = 9 * NLAYER + 1;
#ifndef PHASE_MASK
#define PHASE_MASK 0x3ff
#endif
#define EN(k) (((PHASE_MASK) >> (k)) & 1)
#ifndef ABL_FLAGS
#define ABL_FLAGS 0
#endif
#if ABL_FLAGS
#define ABL_OFF(bit) (!(karg_flags() & (bit)))
#else
#define ABL_OFF(bit) true
#endif
#ifndef PROBE_REP
#define PROBE_REP -1
#endif
#ifndef ATT_V1
#define NATT 1536
#define ATT_UNIT(v) do { const MixP P_ = make_mixp(args, l); da2::unit((v), P_, lds, wave, lane_o); } while (0)
#else
#define NATT 768
#define ATT_UNIT(v) dattn_unit((v), l, args, lds_, wave, lane_o)
#endif
#ifndef PROBE_SKIP
#define PROBE_SKIP 0
#endif
#ifndef PROBE_LAYER
#define PROBE_LAYER 0
#endif
#ifndef UNIT_MASK
#define UNIT_MASK 7
#endif
#define UEN(k) (((UNIT_MASK) >> (k)) & 1)
__device__ __forceinline__ void zero_tile(bf16* MIX, int row0, int nrows, int col0, int tid) {
    for (int i = tid; i < nrows * 16; i += 512) *(GAS v4u*)(MIX + (size_t)(row0 + (i >> 4)) * 2048 + col0 + (i & 15) * 8) = (v4u){0u, 0u, 0u, 0u};
}
__global__ void __launch_bounds__(512, 2) hybrid_fwd(Args args) {
    extern __shared__ __attribute__((aligned(16))) unsigned char lds_[];
    LAS unsigned char* lds = (LAS unsigned char*)lds_;
    const int wave = __builtin_amdgcn_readfirstlane((int)threadIdx.x >> 6);
    const int G = gridDim.x, bx = blockIdx.x;
    const int vcu = (G % 8 == 0) ? (bx % 8) * (G / 8) + bx / 8 : bx;
    const int gw = vcu * 8 + wave, NGW = G * 8;
    unsigned char* ws = karg_ws();
    unsigned* ctl = (unsigned*)(ws + WS_CTL);
    volatile LAS unsigned* MISC = (volatile LAS unsigned*)(lds + MISC_OFF);
    { const int t = wave * 64 + hw_lane(); if (t < 128) MISC[t] = 0u; }
    __syncthreads();
    volatile LAS int* tp = (volatile LAS int*)(lds + MISC_OFF + 64);
#if MK_PER_PHASE
#define GRID_BAR() do { } while (0)
#else
    XcdBarrier bar = xcd_barrier_post(ctl + CW_BAR + XCD_BAR_WORDS * karg_int(220), MISC, wave == 0 && hw_lane() == 0);
#define GRID_BAR() xcd_barrier(bar, wave == 0 && hw_lane() == 0)
#endif
    const int lo = karg_int(208), hi = karg_int(212);
#define IN(k) (lo <= (k) && (k) < hi)
#define OPAQUE_LANE() int tid_o = wave * 64 + hw_lane(); asm volatile("" : "+v"(tid_o)); const int lane_o = tid_o & 63
#define BOTH(k) (IN(k) && IN((k) + 1))
    bf16* BUFA = (bf16*)(ws + WS_BUFA); bf16* BUFB = (bf16*)(ws + WS_BUFB); bf16* PROJ = (bf16*)(ws + WS_PROJ);
    float* RSTD = (float*)(ws + WS_RSTD);

    if (EN(0) && IN(0)) {
        OPAQUE_LANE(); conv_phase(args, lds, gw, NGW, wave, lane_o);
        if (BOTH(0)) GRID_BAR();
    }
#pragma unroll 1
    for (int l = 0; l < NLAYER; ++l) {
        const int pb = 9 * l;
        unsigned* cnt = ctl + CW_CNT + 64 * l;
        if (EN(1) && IN(pb + 1)) {
            OPAQUE_LANE();
            if (l == 0) { if (G1_I8) norm1_i8_phase<false>(l, nullptr, lds, vcu, G, wave, tid_o); else norm1_phase<false>(args, l, nullptr, lds, vcu, G, wave, tid_o); if (G1_I8) { __syncthreads(); quant_win_phase(lds, gw, NGW, wave, lane_o); } }
            else { build_tp(ctl + CW_CNT + 64 * (l - 1), tp, tid_o); if (G1_I8) norm1_i8_phase<true>(l, (const LAS int*)tp, lds, vcu, G, wave, tid_o); else norm1_phase<true>(args, l, (const LAS int*)tp, lds, vcu, G, wave, tid_o); }
            if (BOTH(pb + 1)) GRID_BAR();
        }
        if (EN(2) && IN(pb + 2)) {
            if (G1_SPLIT) {
                { pg8::DenseOrder S; S.init(BUFA, ws + (l ? WS_WIN1 : WS_WIN), MTOK, 14 * 256, 2048, G, bx, 0);
                  pg8::EpiProjQK<false> E{PROJ, NPROJ, RSTD, 1.0f, karg_in(I_QNG) + l * 64, karg_in(I_KNG) + l * 64, (const f32x4*)(ws + WS_ROPE), (LAS float*)(lds + RING_BYTES), nullptr, nullptr};
                  pg8::gemm_phase<pg8::EpiProjQK<false>, pg8::DenseOrder, true, false>(lds + RING_OFF, S, E, wave); }
                { pg8::DenseOrder S; S.init(ws + WS_A8, ws + WS_WIN8 + (size_t)l * 11 * MiB, MTOK, 8 * 256, 1024, G, bx, 1);
                  pg8::EpiBf16 E{PROJ, NPROJ, RSTD, 1.0f / SC_WIN};
                  pg8::gemm_phase<pg8::EpiBf16, pg8::DenseOrder, true, false, 1>(lds + RING_OFF, S, E, wave); }
            } else if (G1_I8) {
                pg8::DenseOrder S; S.init(ws + WS_A8, ws + WS_WIN8 + (size_t)l * 11 * MiB, MTOK, NPROJ, 1024  , G, bx, 2);
                pg8::EpiProjQK<true> E{PROJ, NPROJ, RSTD, 1.0f, karg_in(I_QNG) + l * 64, karg_in(I_KNG) + l * 64, (const f32x4*)(ws + WS_ROPE), (LAS float*)(lds + RING_BYTES), (const unsigned*)(ws + WS_CTL) + CW_CMAX + 8192 * l, (LAS float*)(lds + RING_BYTES + 8192)};
                pg8::gemm_phase<pg8::EpiProjQK<true>, pg8::DenseOrder, true, false, 2>(lds + RING_OFF, S, E, wave);
            } else {
                pg8::DenseOrder S; S.init(BUFA, ws + (l ? WS_WIN1 : WS_WIN), MTOK, NPROJ, 2048, G, bx);
                pg8::EpiProjQK<false> E{PROJ, NPROJ, RSTD, 1.0f, karg_in(I_QNG) + l * 64, karg_in(I_KNG) + l * 64, (const f32x4*)(ws + WS_ROPE), (LAS float*)(lds + RING_BYTES), nullptr, nullptr};
                pg8::gemm_phase<pg8::EpiProjQK<false>, pg8::DenseOrder, true, false>(lds + RING_OFF, S, E, wave);
            }
            if (BOTH(pb + 2)) GRID_BAR();
        }
        if (EN(4) && IN(pb + 4)) {
            { OPAQUE_LANE();
              if (wave == 0) { const float* lp = karg_in(I_LAM) + l * 256; const float la = lp[lane_o] * lp[64 + lane_o], lb = lp[128 + lane_o] * lp[192 + lane_o];
                  const float lam = __expf(wave_sum(la)) - __expf(wave_sum(lb)) + ((l == 0) ? 0.2f : 0.35550906759096934f);
                  if (lane_o == 0) ((volatile LAS float*)MISC)[6] = lam; }
              __syncthreads(); }
            constexpr int QLEN = 12 + 288 + 128;
            unsigned* qh0 = ctl + CW_Q + 2048 * l + 1024 * karg_int(220);
            const int x0 = (int)(xb_xcc_id() & 7u);
            int kq = 0;
            for (;;) {
                OPAQUE_LANE();
                const int xq = (x0 + kq) & 7;
                if (tid_o == 0) {
                    const unsigned pv = MISC[7];
                    if (pv) { MISC[7] = 0u; MISC[4] = pv - 1u; } else MISC[4] = __hip_atomic_fetch_add(qh0 + 64 * xq, 1u, RLX_AGENT);
                    *(volatile LAS unsigned long long*)(MISC + 8) = (unsigned long long)(qh0 + 64 * xq); }
                __syncthreads();
                const int i = __builtin_amdgcn_readfirstlane((int)MISC[4]);
                __syncthreads();
                if (i >= QLEN) { if (++kq == 8) break; continue; }
                if (i < 12) { if (!(karg_flags() & 16)) mlstm_unit(8 * i + xq, l, args, lds, tid_o, wave, lane_o); }
                else if (i < 300) { const int v = i - 12, g3 = v / 3;
                    if (v % 3 == 2) { if (!(karg_flags() & 128)) conv_moe_unit(8 * g3 + xq, l, lds, wave, lane_o); }
                    else if (!(karg_flags() & 32)) { const int a = v - g3, bh = 8 * (a >> 4) + xq; ATT_UNIT((a & 15) * 96 + bh); } }
                else { if (!(karg_flags() & 64)) gmlp_unit(8 * (i - 300) + xq, l, args, lds, tid_o, wave, lane_o); }
            }
            if (BOTH(pb + 4)) GRID_BAR();
        }
        if (EN(5) && IN(pb + 5)) {
            pg8::DenseOrder S; S.init(BUFB, ws + (l ? WS_WOUT1 : WS_WOUT), MTOK, 2048, 2048, G, bx);
            if (l == 0) { pg8::EpiResBf16<true> E{karg_in(I_X), (bf16*)(ws + WS_XB), 2048}; pg8::gemm_phase<pg8::EpiResBf16<true>, pg8::DenseOrder, true, false>(lds + RING_OFF, S, E, wave); }
            else { pg8::EpiResBf16<false> E{ws + WS_XB, (bf16*)(ws + WS_XB), 2048}; pg8::gemm_phase<pg8::EpiResBf16<false>, pg8::DenseOrder, true, false>(lds + RING_OFF, S, E, wave); }
            if (BOTH(pb + 5)) GRID_BAR();
        }
        if (EN(6) && IN(pb + 6)) {
            OPAQUE_LANE(); norm2_sp_phase(l, lds, vcu, G, wave, tid_o);
            if (BOTH(pb + 6)) GRID_BAR();
        }
        if (EN(7) && IN(pb + 7)) {
            { OPAQUE_LANE(); build_tp(cnt, tp, tid_o); }
            pg8::GroupOrder S; S.A = (const char*)(ws + WS_A8); S.Bt = (const char*)(ws + WS_WGU); S.K = 1024  ; S.NJ = 4; S.bstride_e = (size_t)1024 * 2048;
            S.tp = (const LAS int*)tp; S.list = (const int*)(ws + WS_LIST); S.cnt = cnt; S.G = G; S.c = bx; S.gather = true; S.arow_bytes = 0;
            pg8::EpiSwiglu E{ws + WS_HID, RSTD, S, 1.0f / SC_WGU};
            pg8::gemm_phase<pg8::EpiSwiglu, pg8::GroupOrder, true, true, 1>(lds + RING_OFF, S, E, wave);
            if (BOTH(pb + 7)) GRID_BAR();
        }
        if (EN(8) && IN(pb + 8)) {
            pg8::GroupOrder S; S.A = (const char*)(ws + WS_HID); S.Bt = (const char*)(ws + WS_WD); S.K = 256  ; S.NJ = 8; S.bstride_e = (size_t)2048 * 512;
            S.tp = (const LAS int*)tp; S.list = nullptr; S.cnt = cnt; S.G = G; S.c = bx; S.gather = false; S.arow_bytes = (size_t)512;
            pg8::EpiFp8 E{ws + WS_Y, 2048, 1.0f / SC_WD};
            pg8::gemm_phase<pg8::EpiFp8, pg8::GroupOrder, true, false, 1>(lds + RING_OFF, S, E, wave);
            if (BOTH(pb + 8)) GRID_BAR();
        }
    }
    if (EN(9) && IN(9 * NLAYER)) {
        OPAQUE_LANE(); build_tp(ctl + CW_CNT + 64 * (NLAYER - 1), tp, tid_o);
        final_phase(args, (const LAS int*)tp, gw, NGW, lane_o);
    }
#undef IN
#undef BOTH
}

extern "C" void kernel_launch(void* const* d_in, const int* in_sizes, int n_in, void* d_out, int out_size, void* d_ws, size_t ws_size, hipStream_t stream) {
    static int grid = 0;
    if (grid == 0) {
        if (n_in != 24 || in_sizes[0] != MTOK * DMODEL || out_size != MTOK * DMODEL || ws_size < WS_END) {
            fprintf(stderr, "kernel_launch: unexpected problem (n_in %d, in0 %d, out %d, ws %zu < %zu); nothing launched\n", n_in, n_in > 0 ? in_sizes[0] : -1, out_size, ws_size, (size_t)WS_END); grid = -1; return; }
        int dev = 0, cus = 0, per_cu = 0;
        if (hipGetDevice(&dev) != hipSuccess || hipDeviceGetAttribute(&cus, hipDeviceAttributeMultiprocessorCount, dev) != hipSuccess) { grid = -1; return; }
        if (hipFuncSetAttribute((const void*)hybrid_fwd, hipFuncAttributeMaxDynamicSharedMemorySize, LDS_BYTES) != hipSuccess) { fprintf(stderr, "kernel_launch: hipFuncSetAttribute failed\n"); grid = -1; return; }
        if (hipOccupancyMaxActiveBlocksPerMultiprocessor(&per_cu, (const void*)hybrid_fwd, 512, LDS_BYTES) != hipSuccess || per_cu < 1)
            fprintf(stderr, "kernel_launch: note: occupancy query reports %d workgroups per CU\n", per_cu);
        (void)hipGetLastError();
        grid = cus;
    }
    if (grid < 0) return;
    if (hipMemsetAsync((char*)d_ws + WS_CTL, 0, CTL_ZERO_BYTES, stream) != hipSuccess) return;
    Args a{};
    for (int i = 0; i < 24; ++i) a.in[i] = (const float*)d_in[i];
    a.out = (float*)d_out; a.ws = (unsigned char*)d_ws; a.flags = ABL_FLAGS; a.pad = 0;
#if MK_PER_PHASE
    for (int p = 0; p < NPHASE; ++p) { a.ph_lo = p; a.ph_hi = p + 1; hipLaunchKernelGGL(hybrid_fwd, dim3(grid), dim3(512), LDS_BYTES, stream, a); }
#else
#if PROBE_REP >= 0
    a.ph_lo = 0; a.ph_hi = 9 * PROBE_LAYER + PROBE_REP + 1; a.pad = 0;
    hipLaunchKernelGGL(hybrid_fwd, dim3(grid), dim3(512), LDS_BYTES, stream, a);
    a.ph_lo = 9 * PROBE_LAYER + PROBE_REP; a.ph_hi = a.ph_lo + 1; a.pad = 1; a.flags |= PROBE_SKIP;
#ifdef PROBE_EMPTY
    a.ph_hi = a.ph_lo;
#endif
    hipLaunchKernelGGL(hybrid_fwd, dim3(grid), dim3(512), LDS_BYTES, stream, a);
    a.ph_lo = 9 * PROBE_LAYER + PROBE_REP + 1; a.ph_hi = NPHASE; a.pad = 2; a.flags &= ~PROBE_SKIP;
    hipLaunchKernelGGL(hybrid_fwd, dim3(grid), dim3(512), LDS_BYTES, stream, a);
#else
    a.ph_lo = 0; a.ph_hi = NPHASE;
    hipLaunchKernelGGL(hybrid_fwd, dim3(grid), dim3(512), LDS_BYTES, stream, a);
#endif
#endif
    const hipError_t le = hipPeekAtLastError();
    if (le != hipSuccess) fprintf(stderr, "kernel_launch: launch failed: %s\n", hipGetErrorName(le));
}
```

```cpp
#include <hip/hip_runtime.h>
#include <hip/hip_bf16.h>
#include <cstdio>
#include <cstdint>
#include <cmath>

#ifndef MK_PER_PHASE
#define MK_PER_PHASE 0
#endif

#define GAS __attribute__((address_space(1)))
#define LAS __attribute__((address_space(3)))
typedef unsigned short bf16;
typedef unsigned v4u __attribute__((ext_vector_type(4)));
typedef unsigned v2u __attribute__((ext_vector_type(2)));
typedef float f32x4 __attribute__((ext_vector_type(4)));
typedef float f32x2 __attribute__((ext_vector_type(2)));
typedef float f32x16 __attribute__((ext_vector_type(16)));
typedef short bf16x8 __attribute__((ext_vector_type(8)));
typedef short s16x4 __attribute__((ext_vector_type(4)));
typedef GAS unsigned gu32;
#define RLX_AGENT __ATOMIC_RELAXED, __HIP_MEMORY_SCOPE_AGENT
#define LDS_WAIT() asm volatile("s_waitcnt lgkmcnt(0)" ::: "memory")
#define VM_WAIT() asm volatile("s_waitcnt vmcnt(0)" ::: "memory")

constexpr int NBATCH = 16, SEQ = 2048, DMODEL = 2048, MTOK = NBATCH * SEQ;
constexpr int DIN = 5644, NPROJ = 5632;
constexpr int C_GMU = 0, C_GMV = 512, C_MLQ = 1024, C_MLK = 1408, C_MLV = 1792, C_MLO = 2560, C_DAQ = 3328, C_DAK = 4096, C_DAV = 4864;
constexpr int SRC_GATE = 3328;
constexpr int NEXP = 32, DEXP = 512, SLOT_ROWS = 73728;
constexpr int NLAYER = 2;
constexpr float EPS = 1e-6f;
#ifndef G1_I8
#define G1_I8 1
#endif
#ifndef G1_SPLIT
#define G1_SPLIT 0
#endif
constexpr float SC_WIN = 64.0f;
constexpr float SC_WGU = 64.0f, SC_WD = 32.0f;
constexpr float QSCALE = 0.125f * 1.4426950408889634f;

constexpr size_t MiB = 1u << 20;
constexpr size_t WS_CTL = 0, CTL_ZERO_BYTES = 1 * MiB;
constexpr size_t WS_RWG = 1 * MiB;
constexpr size_t WS_RWR = 1 * MiB + 128 * 1024;
constexpr size_t RW_LSTRIDE = 512 * 1024;
constexpr size_t WS_WIN8 = 127 * MiB;
constexpr size_t WS_ROPE = 126 * MiB;
constexpr size_t WS_WIN = 2 * MiB, WS_WIN1 = 96 * MiB;
constexpr size_t WS_WOUT = 24 * MiB, WS_WOUT1 = 118 * MiB;
constexpr size_t WS_WGU = 32 * MiB;
constexpr size_t WS_WD = 160 * MiB;
constexpr size_t WS_BUFA = 224 * MiB;
constexpr size_t WS_BUFB = 352 * MiB;
constexpr size_t WS_PROJ = 480 * MiB;
constexpr size_t WS_HID = WS_PROJ;
constexpr size_t WS_Y = WS_PROJ + 72 * MiB;
constexpr size_t WS_GATES = 840 * MiB;
constexpr size_t WS_RSTD = 842 * MiB;
constexpr size_t WS_ROUTE = 843 * MiB;
constexpr size_t WS_LIST = 844 * MiB;
constexpr size_t WS_A8 = 848 * MiB;
constexpr size_t WS_XB = 912 * MiB;
constexpr size_t WS_END = 1040 * MiB;
constexpr int CW_TMO = 0, CW_CODE = 1;
constexpr int CW_BAR = 4096;
constexpr int CW_CNT = 16384;
constexpr int CW_CMAX = 32768;
constexpr int CW_Q = 16384 + 256;

constexpr int RING_OFF = 0, RING_BYTES = 131072;
constexpr int LDS_PHASE_BYTES = 151552;
constexpr int MISC_OFF = LDS_PHASE_BYTES;
constexpr int LDS_BYTES = LDS_PHASE_BYTES + 512;

__device__ __forceinline__ int hw_lane() { int l; asm volatile("v_mbcnt_lo_u32_b32 %0, -1, 0\n\tv_mbcnt_hi_u32_b32 %0, -1, %0" : "=v"(l)); return l; }
__device__ __forceinline__ float sx(float v, int m) {
    const int x = __float_as_int(v);
    if (m == 1) return __int_as_float(__builtin_amdgcn_mov_dpp(x, 0xB1, 0xf, 0xf, true));
    if (m == 2) return __int_as_float(__builtin_amdgcn_mov_dpp(x, 0x4E, 0xf, 0xf, true));
    if (m == 4) { int r = __builtin_amdgcn_update_dpp(x, x, 0x104, 0xf, 0x5, false);
                  r = __builtin_amdgcn_update_dpp(r, x, 0x114, 0xf, 0xA, false); return __int_as_float(r); }
    if (m == 8) return __int_as_float(__builtin_amdgcn_mov_dpp(x, 0x128, 0xf, 0xf, true));
    if (m == 16) { auto rr = __builtin_amdgcn_permlane16_swap((unsigned)x, (unsigned)x, false, false); return __uint_as_float(((hw_lane() >> 4) & 1) ? rr[0] : rr[1]); }
    if (m == 32) { auto rr = __builtin_amdgcn_permlane32_swap((unsigned)x, (unsigned)x, false, false); return __uint_as_float((hw_lane() >> 5) ? rr[0] : rr[1]); }
    return __int_as_float(__builtin_amdgcn_ds_bpermute((hw_lane() ^ m) << 2, x));
}
__device__ __forceinline__ float sidx(float v, int i) { return __int_as_float(__builtin_amdgcn_ds_bpermute(i << 2, __float_as_int(v))); }
__device__ __forceinline__ float sup(float v, int d) { return __int_as_float(__builtin_amdgcn_ds_bpermute((hw_lane() - d) << 2, __float_as_int(v))); }
__device__ __forceinline__ unsigned f2bf(float f) { unsigned u = __builtin_bit_cast(unsigned, f); return (u + 0x7fffu + ((u >> 16) & 1u)) >> 16; }
__device__ __forceinline__ float bf2f(unsigned h) { return __builtin_bit_cast(float, h << 16); }
typedef __bf16 bf16x2_t __attribute__((ext_vector_type(2)));
__device__ __forceinline__ unsigned pk2(float lo, float hi) { f32x2 v = {lo, hi}; bf16x2_t b = __builtin_convertvector(v, bf16x2_t); return __builtin_bit_cast(unsigned, b); }
__device__ __forceinline__ unsigned pk_fp8x4(float a, float b, float c, float d) { unsigned w = 0u; w = __builtin_amdgcn_cvt_pk_fp8_f32(a, b, w, false); w = __builtin_amdgcn_cvt_pk_fp8_f32(c, d, w, true); return w; }
__device__ __forceinline__ void unpack_fp8x8(v2u w, float (&x)[8]) { f32x2 a = __builtin_amdgcn_cvt_pk_f32_fp8(w.x, false), b = __builtin_amdgcn_cvt_pk_f32_fp8(w.x, true), c = __builtin_amdgcn_cvt_pk_f32_fp8(w.y, false), d = __builtin_amdgcn_cvt_pk_f32_fp8(w.y, true);
    x[0] = a.x; x[1] = a.y; x[2] = b.x; x[3] = b.y; x[4] = c.x; x[5] = c.y; x[6] = d.x; x[7] = d.y; }
__device__ __forceinline__ float lo_f(unsigned w) { return __builtin_bit_cast(float, w << 16); }
__device__ __forceinline__ float hi_f(unsigned w) { return __builtin_bit_cast(float, w & 0xffff0000u); }
__device__ __forceinline__ float wave_sum(float v) {
#pragma unroll
    for (int o = 1; o < 64; o <<= 1) v += sx(v, o);
    return v;
}
__device__ __forceinline__ float gelu_f(float v) {
    const float av = __builtin_fabsf(v), t = __builtin_amdgcn_rcpf(av * 0.2316418882f + 1.0f);
    float q = t * 0.5307027145f + (-0.7265760135f); q = q * t + 0.7107068705f; q = q * t + (-0.142248368f); q = q * t + 0.127414796f; q = q * t;
    const float e = __builtin_amdgcn_exp2f((v * v) * (-0.72134752044f));
    const float m = v * (q * e);
    return v < 0.f ? m : v - m;
}
__device__ __forceinline__ float silu_f(float v) { return v / (1.0f + __expf(-v)); }
__device__ __forceinline__ float sigmoid_f(float v) { return 1.0f / (1.0f + __expf(-v)); }

#define XB_TMO      128
#define XB_XCNT(j)  (256  + 64 * (j))
#define XB_XSUB(j)  (1280 + 64 * (j))
#define XB_XGEN(j)  (2304 + 64 * (j))
#define XB_TOP      3328
#define XB_TOPGEN   3392
#define XCD_BAR_WORDS 3456
#define XB_SPIN_CAP (1u << 18)

__device__ __forceinline__ unsigned xb_ld(unsigned* p)              { return __hip_atomic_load(p, __ATOMIC_RELAXED, __HIP_MEMORY_SCOPE_AGENT); }
__device__ __forceinline__ unsigned xb_add(unsigned* p, unsigned v) { return __hip_atomic_fetch_add(p, v, __ATOMIC_RELAXED, __HIP_MEMORY_SCOPE_AGENT); }
__device__ __forceinline__ unsigned xb_xcc_id() { return (unsigned)__builtin_amdgcn_s_getreg((3 << 11) | 20) & 0xFu; }
#define XB_SPIN(cond, bar) do { unsigned _sp = 0; while (cond) { __builtin_amdgcn_s_sleep(1); \
    if ((++_sp & 255u) == 0u) { if (xb_ld(&(bar)[XB_TMO])) break; if (_sp > XB_SPIN_CAP) { atomicAdd(&(bar)[XB_TMO], 1u); break; } } } } while (0)

struct XcdBarrier {
    unsigned* bar; unsigned x;
    volatile LAS unsigned* st;
};

__device__ __forceinline__ XcdBarrier xcd_barrier_post(unsigned* bar, volatile LAS unsigned* st, bool t0  ) {
    XcdBarrier b; b.bar = bar; b.x = xb_xcc_id(); b.st = st;
    if (t0) (void)xb_add(&bar[XB_XCNT(b.x)], 1u);
    return b;
}
__device__ __forceinline__ void xcd_barrier_complete(unsigned* bar, unsigned x, unsigned& nloc, unsigned& nx) {
    const unsigned G = gridDim.x * gridDim.y * gridDim.z;
    unsigned sum, cnt, mine, sp = 0u;
    for (;;) {
        sum = 0u; cnt = 0u; mine = 0u;
#pragma unroll 1
        for (unsigned j = 0; j < 16; ++j) { const unsigned c = xb_ld(&bar[XB_XCNT(j)]); sum += c; cnt += (c > 0u) ? 1u : 0u; mine = (j == x) ? c : mine; }
        if (sum == G) break;
        __builtin_amdgcn_s_sleep(1);
        if ((++sp & 255u) == 0u) { if (xb_ld(&bar[XB_TMO])) break; if (sp > XB_SPIN_CAP) { atomicAdd(&bar[XB_TMO], 1u); break; } }
    }
    nloc = mine > 0u ? mine : 1u; nx = cnt > 0u ? cnt : 1u;
}

__device__ __forceinline__ void xcd_barrier(const XcdBarrier& b, bool t0  ) {
    asm volatile("s_waitcnt vmcnt(0)" ::: "memory");
    __syncthreads();
    if (t0) {
        unsigned* bar = b.bar;
        __builtin_amdgcn_s_waitcnt(0);
        unsigned nloc = b.st[0], nx = b.st[1];
        if (nloc == 0u) { xcd_barrier_complete(bar, b.x, nloc, nx); b.st[0] = nloc; b.st[1] = nx; }
        const unsigned old = xb_add(&bar[XB_XSUB(b.x)], 1u);
        const unsigned gen = old / nloc;
        if (old + 1u == (gen + 1u) * nloc) {
            __builtin_amdgcn_fence(__ATOMIC_RELEASE, "agent");
            asm volatile("s_waitcnt vmcnt(0)" ::: "memory");
            const unsigned og = xb_add(&bar[XB_TOP], 1u);
            const unsigned tg = og / nx;
            if (og + 1u == (tg + 1u) * nx) xb_add(&bar[XB_TOPGEN], 1u);
            else XB_SPIN(xb_ld(&bar[XB_TOPGEN]) == tg, bar);
            __builtin_amdgcn_fence(__ATOMIC_ACQUIRE, "agent");
            xb_add(&bar[XB_XGEN(b.x)], 1u);
            asm volatile("s_waitcnt vmcnt(0)" ::: "memory");
        } else {
            XB_SPIN(xb_ld(&bar[XB_XGEN(b.x)]) == gen, bar);
            __builtin_amdgcn_fence(__ATOMIC_ACQUIRE, "agent");
            asm volatile("s_waitcnt vmcnt(0)" ::: "memory");
        }
    }
    __syncthreads();
}

#ifndef PROBE_REP
#define PROBE_REP -1
#endif
__device__ __forceinline__ int gemm_probe_flags();
namespace pg8 {
constexpr int BM = 256, BK = 64, HALF = 128, HTB = HALF * BK * 2  , STAGE_BYTES = 8 * HTB, NXCD = 8, WGM = 4;
__host__ __device__ __forceinline__ int lds_byte(int r, int c) { const int st = (r >> 4) * 2 + (c >> 5), rr = r & 15, cc = c & 31, ob = rr * 64 + cc * 2; return st * 1024 + (ob ^ (((ob >> 9) & 1) << 5)); }
__host__ __device__ __forceinline__ void stage_rc(int b, int& R, int& C) { const int st = b / 1024, sb = b % 1024, swz = sb ^ (((sb >> 9) & 1) << 5); R = (st >> 1) * 16 + swz / 64; C = (st & 1) * 32 + (swz % 64) / 2; }
__host__ __device__ __forceinline__ int perm32(int rho) { const int n = rho >> 4, i = rho & 15; return 8 * (i >> 2) + 4 * n + (i & 3); }

typedef int v4i_t __attribute__((ext_vector_type(4)));
typedef int v8i_t __attribute__((ext_vector_type(8)));
struct Unit { int pm, pn, e; };

__device__ __forceinline__ int g1_tile(int which, int j) {
    if (which == 2) { const int t[22] = {13, 14, 15, 16, 17, 18, 0, 1, 2, 3, 4, 5, 6, 7, 8, 9, 10, 11, 12, 19, 20, 21}; int r = t[0];
#pragma unroll
        for (int k = 1; k < 22; ++k) r = (j == k) ? t[k] : r; return r; }
    if (which == 0) { const int t[14] = {0, 1, 4, 5, 6, 10, 11, 12, 13, 14, 15, 16, 17, 18}; int r = t[0];
#pragma unroll
        for (int k = 1; k < 14; ++k) r = (j == k) ? t[k] : r; return r; }
    const int t[8] = {2, 3, 7, 8, 9, 19, 20, 21}; int r = t[0];
#pragma unroll
    for (int k = 1; k < 8; ++k) r = (j == k) ? t[k] : r; return r;
}
struct DenseOrder {
    const char* A; const char* Bt; int K; int nM, nN, nwg, G, c; int tl;
    __device__ void init(const void* A_, const void* Bt_, int M, int N, int K_, int G_, int c_, int tl_ = -1) { A = (const char*)A_; Bt = (const char*)Bt_; K = K_; nM = M / BM; nN = N / BM; nwg = nM * nN; G = G_; c = c_; tl = tl_; }
    __device__ __forceinline__ bool next(int i, Unit& u) const {
        const long L = (long)i * G + c; if (L >= nwg) return false;
        int wgid = (int)L; { const int q = nwg / NXCD, r = nwg % NXCD, xcd = wgid % NXCD, off = wgid / NXCD; wgid = (xcd < r ? xcd * (q + 1) : r * (q + 1) + (xcd - r) * q) + off; }
        const int nig = WGM * nN, gid = wgid / nig, fm = gid * WGM, gsz = (nM - fm) < WGM ? (nM - fm) : WGM;
        u.pm = fm + ((wgid % nig) % gsz); const int j = (wgid % nig) / gsz; u.pn = tl < 0 ? j : g1_tile(tl, j); u.e = 0; return true;
    }
    __device__ __forceinline__ const char* aptr(const Unit& u) const { return A + (size_t)u.pm * BM * K * 2; }
    __device__ __forceinline__ const char* bptr(const Unit& u) const { return Bt + (size_t)u.pn * BM * K * 2; }
    __device__ __forceinline__ unsigned arow(const Unit&, int r) const { return (unsigned)r; }
};
struct GroupOrder {
    const char* A; const char* Bt; int K; int NJ; size_t bstride_e;
    const LAS int* tp; const int* list; const unsigned* cnt; int G, c; bool gather; size_t arow_bytes;
    __device__ __forceinline__ bool next(int i, Unit& u) const {
        const int T = tp[32]; int rt, jn;
        if (NJ == 8 && (G & 15) == 0) { const int x = c & 7, y = c >> 3, per = G >> 3;
            rt = i * per + (y >> 1) + (per >> 1) * (x >> 2); jn = 2 * (x & 3) + (y & 1); if (rt >= T) return false; }
        else { const int L = i * G + c; if (L >= T * NJ) return false; rt = L / NJ; jn = L - rt * NJ; }
        u.pn = jn; u.pm = rt;
        const int tv = tp[hw_lane() & 31];
        u.e = __builtin_popcount((unsigned)__ballot(tv <= rt)) - 1; return true;
    }
    __device__ __forceinline__ const char* aptr(const Unit& u) const { return gather ? A : A + (size_t)u.pm * BM * arow_bytes; }
    __device__ __forceinline__ const char* bptr(const Unit& u) const { return Bt + (size_t)u.e * bstride_e + (size_t)u.pn * BM * K * 2; }
    __device__ __forceinline__ unsigned arow(const Unit& u, int r) const {
        const int i = (u.pm - tp[u.e]) * BM + r; const unsigned n = cnt[u.e];
        return ((unsigned)i < n) ? (unsigned)list[u.e * 32768 + i] : 0u;
    }
};

__device__ __forceinline__ unsigned cvt_pk_bf16(float lo, float hi) { unsigned r; asm volatile("v_cvt_pk_bf16_f32 %0, %1, %2" : "=v"(r) : "v"(lo), "v"(hi)); return r; }

struct EpiBf16 {
    static constexpr bool PERM = true; static constexpr bool SCL = false;
    bf16* O; int ldc; const float* rs; float cs;
    __device__ __forceinline__ void operator()(const f32x4 (&acc)[2][2][4][2], const Unit& u, int wr, int wc, int fr, int fq) const {
        const int row0 = u.pm * BM + wr * 64 + fr; const int col0 = u.pn * BM + wc * 32 + 8 * fq;
        float sc[2][4];
#pragma unroll
        for (int ai = 0; ai < 2; ++ai)
#pragma unroll
            for (int m = 0; m < 4; ++m) sc[ai][m] = rs ? rs[row0 + ai * HALF + m * 16] * cs : cs;
#pragma unroll
        for (int ai = 0; ai < 2; ++ai)
#pragma unroll
            for (int m = 0; m < 4; ++m) { const int row = row0 + ai * HALF + m * 16; bf16* rowp = O + (size_t)row * ldc + col0;
#pragma unroll
                for (int bj = 0; bj < 2; ++bj) { const f32x4 v0 = acc[ai][bj][m][0] * sc[ai][m], v1 = acc[ai][bj][m][1] * sc[ai][m];
                    v4u w; w.x = cvt_pk_bf16(v0[0], v0[1]); w.y = cvt_pk_bf16(v0[2], v0[3]); w.z = cvt_pk_bf16(v1[0], v1[1]); w.w = cvt_pk_bf16(v1[2], v1[3]);
                    *(v4u*)(rowp + bj * HALF) = w; } }
    }
};
struct EpiFp8 {
    static constexpr bool PERM = true; static constexpr bool SCL = false;
    unsigned char* O; int ldc; float cs;
    __device__ __forceinline__ void operator()(const f32x4 (&acc)[2][2][4][2], const Unit& u, int wr, int wc, int fr, int fq) const {
        const int row0 = u.pm * BM + wr * 64 + fr; const int col0 = u.pn * BM + wc * 32 + 8 * fq;
#pragma unroll
        for (int ai = 0; ai < 2; ++ai)
#pragma unroll
            for (int m = 0; m < 4; ++m) { unsigned char* rowp = O + (size_t)(row0 + ai * HALF + m * 16) * ldc + col0;
#pragma unroll
                for (int bj = 0; bj < 2; ++bj) { const f32x4 v0 = acc[ai][bj][m][0] * cs, v1 = acc[ai][bj][m][1] * cs;
                    v2u w; w.x = pk_fp8x4(v0[0], v0[1], v0[2], v0[3]); w.y = pk_fp8x4(v1[0], v1[1], v1[2], v1[3]);
                    *(v2u*)(rowp + bj * HALF) = w; } }
    }
};
struct EpiResF32 {
    static constexpr bool PERM = false; static constexpr bool SCL = false;
    const float* res; float* out; int ldc;
    __device__ __forceinline__ void operator()(const f32x4 (&acc)[2][2][4][2], const Unit& u, int wr, int wc, int fr, int fq) const {
        const int row0 = u.pm * BM + wr * 64 + fr; const int col0 = u.pn * BM + wc * 32 + 4 * fq;
#pragma unroll
        for (int ai = 0; ai < 2; ++ai) {
            f32x4 r[4][2][2];
#pragma unroll
            for (int m = 0; m < 4; ++m)
#pragma unroll
                for (int bj = 0; bj < 2; ++bj)
#pragma unroll
                    for (int n = 0; n < 2; ++n) r[m][bj][n] = *(const f32x4*)(res + (size_t)(row0 + ai * HALF + m * 16) * ldc + col0 + bj * HALF + n * 16);
#pragma unroll
            for (int m = 0; m < 4; ++m)
#pragma unroll
                for (int bj = 0; bj < 2; ++bj)
#pragma unroll
                    for (int n = 0; n < 2; ++n) *(f32x4*)(out + (size_t)(row0 + ai * HALF + m * 16) * ldc + col0 + bj * HALF + n * 16) = r[m][bj][n] + acc[ai][bj][m][n];
        }
    }
};
__device__ constexpr float ROPE_FH[8] = {0.15911865234375f, 0.03086090087890625f, 0.0059833526611328125f, 0.0011606216430664062f, 0.000225067138671875f, 4.3645501136779785e-05f, 8.4638595581054688e-06f, 1.6409903764724731e-06f};
__device__ constexpr float ROPE_FL[8] = {3.62907485e-05f, 2.86252589e-06f, 1.83305156e-06f, 4.19981738e-08f, 1.19403678e-08f, 2.45165599e-09f, 4.7125015e-10f, 4.35886327e-10f};
template <bool I8> struct EpiProjQK {
    static constexpr bool PERM = true; static constexpr bool SCL = I8;
    bf16* O; int ldc; const float* rs; float cs; const float* qg; const float* kg; const f32x4* rope; LAS float* xch; const unsigned* cmax; LAS float* scl;
    __device__ __forceinline__ void stage(const Unit& u, int wid) const {
        if (wid < 2) { const unsigned* src = (wid == 0 ? (const unsigned*)rs + u.pm * BM : cmax + u.pn * BM) + hw_lane() * 4;
            __builtin_amdgcn_global_load_lds(src, (LAS unsigned*)(scl + u.e * 512 + wid * 256), 16, 0, 0); }
    }
    __device__ __forceinline__ void operator()(const f32x4 (&acc)[2][2][4][2], const Unit& u, int wr, int wc, int fr_, int fq_) const {
        const int ln_ = hw_lane(), fr = ln_ & 15, fq = ln_ >> 4; (void)fr_; (void)fq_;
        const int row0 = u.pm * BM + wr * 64 + fr; const int col0 = u.pn * BM + wc * 32 + 8 * fq;
        float sc[2][4];
#pragma unroll
        for (int ai = 0; ai < 2; ++ai)
#pragma unroll
            for (int m = 0; m < 4; ++m) sc[ai][m] = (I8 ? scl[u.e * 512 + wr * 64 + fr + ai * HALF + m * 16] : rs[row0 + ai * HALF + m * 16]) * cs;
        float wsc[2][8];
#pragma unroll
        for (int bj = 0; bj < 2; ++bj)
#pragma unroll
            for (int e = 0; e < 8; ++e) wsc[bj][e] = I8 ? scl[u.e * 512 + 256 + wc * 32 + 8 * fq + bj * HALF + e] * (1.0f / 127.0f) : 1.0f;
#define EPQ_V(ai_, bj_, m_, n_, k_) ((I8 ? (float)__float_as_int(acc[ai_][bj_][m_][n_][k_]) : acc[ai_][bj_][m_][n_][k_]) * wsc[bj_][(n_) * 4 + (k_)])
        const bool isqk = u.pn >= 13 && u.pn < 19;
        if (!isqk) {
#pragma unroll
            for (int ai = 0; ai < 2; ++ai)
#pragma unroll
                for (int m = 0; m < 4; ++m) { bf16* rowp = O + (size_t)(row0 + ai * HALF + m * 16) * ldc + col0;
#pragma unroll
                    for (int bj = 0; bj < 2; ++bj) { const float r_ = sc[ai][m];
                        v4u w; w.x = cvt_pk_bf16(EPQ_V(ai, bj, m, 0, 0) * r_, EPQ_V(ai, bj, m, 0, 1) * r_); w.y = cvt_pk_bf16(EPQ_V(ai, bj, m, 0, 2) * r_, EPQ_V(ai, bj, m, 0, 3) * r_);
                        w.z = cvt_pk_bf16(EPQ_V(ai, bj, m, 1, 0) * r_, EPQ_V(ai, bj, m, 1, 1) * r_); w.w = cvt_pk_bf16(EPQ_V(ai, bj, m, 1, 2) * r_, EPQ_V(ai, bj, m, 1, 3) * r_);
                        *(v4u*)(rowp + bj * HALF) = w; } }
            return;
        }
        const int half = wc & 1, mp = wc >> 1;
#pragma unroll
        for (int ai = 0; ai < 2; ++ai)
#pragma unroll
            for (int m = 0; m < 4; ++m)
#pragma unroll
                for (int bj = 0; bj < 2; ++bj) { const float r_ = sc[ai][m]; float s = 0.f;
#pragma unroll
                    for (int n = 0; n < 2; ++n)
#pragma unroll
                        for (int k = 0; k < 4; ++k) { const float v_ = EPQ_V(ai, bj, m, n, k) * r_; s += v_ * v_; }
                    { auto r16 = __builtin_amdgcn_permlane16_swap(__float_as_uint(s), __float_as_uint(s), false, false); s = __uint_as_float(r16[0]) + __uint_as_float(r16[1]);
                      auto r32 = __builtin_amdgcn_permlane32_swap(__float_as_uint(s), __float_as_uint(s), false, false); s = __uint_as_float(r32[0]) + __uint_as_float(r32[1]); }
                    if (fq == 0) xch[((ai * HALF + wr * 64 + m * 16 + fr) * 4 + bj * 2 + mp) * 2 + half] = s; }
        const bool isq = u.pn < 16; const float* gsrc = (isq ? qg : kg) + 32 * half + 8 * fq; float g[2][8];
#pragma unroll
        for (int bj = 0; bj < 2; ++bj)
#pragma unroll
            for (int e = 0; e < 8; ++e) g[bj][e] = gsrc[e] * (isq ? QSCALE : 1.0f) * wsc[bj][e];
        asm volatile("s_waitcnt lgkmcnt(0)" ::: "memory"); __builtin_amdgcn_s_barrier(); asm volatile("" ::: "memory");
#define EPQ_R(ai_, bj_, m_, n_, k_) (I8 ? (float)__float_as_int(acc[ai_][bj_][m_][n_][k_]) : acc[ai_][bj_][m_][n_][k_])
#pragma unroll
        for (int ai = 0; ai < 2; ++ai)
#pragma unroll
            for (int m = 0; m < 4; ++m) { const int rt = ai * HALF + wr * 64 + m * 16 + fr, row = u.pm * BM + rt; bf16* rowp = O + (size_t)row * ldc + col0;
                float rcs[8], rsn[8];
                if (half == 0) { const float pos = (float)(row & (SEQ - 1));
#pragma unroll
                    for (int e = 0; e < 8; ++e) { const float t = __builtin_amdgcn_fractf(pos * ROPE_FH[e]) + pos * ROPE_FL[e]; rcs[e] = __builtin_amdgcn_cosf(t); rsn[e] = __builtin_amdgcn_sinf(t); } }
#pragma unroll
                for (int bj = 0; bj < 2; ++bj) { const LAS float* xp = xch + (rt * 4 + bj * 2 + mp) * 2;
                    const float rn = sc[ai][m] / sqrtf((xp[0] + xp[1]) * (1.0f / 64.0f) + EPS);
                    float x[8];
#pragma unroll
                    for (int n = 0; n < 2; ++n)
#pragma unroll
                        for (int k = 0; k < 4; ++k) x[n * 4 + k] = EPQ_R(ai, bj, m, n, k) * rn * g[bj][n * 4 + k];
                    if (half == 0) {
                        float px[8];
#pragma unroll
                        for (int e = 0; e < 8; ++e) { auto rr = __builtin_amdgcn_permlane16_swap(__float_as_uint(x[e]), __float_as_uint(x[e]), false, false); px[e] = __uint_as_float((fq & 1) ? rr[0] : rr[1]); }
                        if (fq < 2) {
#pragma unroll
                            for (int e = 0; e < 8; ++e) x[e] = (fq == 0) ? x[e] * rcs[e] - px[e] * rsn[e] : x[e] * rcs[e] + px[e] * rsn[e];
                        }
                    }
                    v4u w; w.x = cvt_pk_bf16(x[0], x[1]); w.y = cvt_pk_bf16(x[2], x[3]); w.z = cvt_pk_bf16(x[4], x[5]); w.w = cvt_pk_bf16(x[6], x[7]);
                    *(v4u*)(rowp + bj * HALF) = w; }
                __builtin_amdgcn_sched_barrier(0); }
#undef EPQ_V
#undef EPQ_R
    }
};
template <bool RESF32> struct EpiResBf16 {
    static constexpr bool PERM = true; static constexpr bool SCL = false;
    const void* res; bf16* out; int ldc;
    __device__ __forceinline__ void operator()(const f32x4 (&acc)[2][2][4][2], const Unit& u, int wr, int wc, int fr, int fq) const {
        const int row0 = u.pm * BM + wr * 64 + fr; const int col0 = u.pn * BM + wc * 32 + 8 * fq;
#pragma unroll
        for (int ai = 0; ai < 2; ++ai) {
            f32x4 r[4][2][2];
#pragma unroll
            for (int m = 0; m < 4; ++m)
#pragma unroll
                for (int bj = 0; bj < 2; ++bj) { const size_t o = (size_t)(row0 + ai * HALF + m * 16) * ldc + col0 + bj * HALF;
                    if constexpr (RESF32) { r[m][bj][0] = *(const f32x4*)((const float*)res + o); r[m][bj][1] = *(const f32x4*)((const float*)res + o + 4); }
                    else { const v4u w = *(const v4u*)((const bf16*)res + o); r[m][bj][0] = (f32x4){lo_f(w.x), hi_f(w.x), lo_f(w.y), hi_f(w.y)}; r[m][bj][1] = (f32x4){lo_f(w.z), hi_f(w.z), lo_f(w.w), hi_f(w.w)}; } }
#pragma unroll
            for (int m = 0; m < 4; ++m)
#pragma unroll
                for (int bj = 0; bj < 2; ++bj) { const f32x4 v0 = r[m][bj][0] + acc[ai][bj][m][0], v1 = r[m][bj][1] + acc[ai][bj][m][1];
                    v4u w; w.x = cvt_pk_bf16(v0[0], v0[1]); w.y = cvt_pk_bf16(v0[2], v0[3]); w.z = cvt_pk_bf16(v1[0], v1[1]); w.w = cvt_pk_bf16(v1[2], v1[3]);
                    *(v4u*)(out + (size_t)(row0 + ai * HALF + m * 16) * ldc + col0 + bj * HALF) = w; }
        }
    }
};
struct EpiSwiglu {
    static constexpr bool PERM = true; static constexpr bool SCL = false;
    unsigned char* O; const float* rstd; GroupOrder S; float cs;
    __device__ __forceinline__ void operator()(const f32x4 (&acc)[2][2][4][2], const Unit& u, int wr, int wc, int fr, int fq) const {
        const int col0 = u.pn * HALF + wc * 32 + 8 * fq;
        unsigned tok[2][4]; float sc[2][4];
#pragma unroll
        for (int ai = 0; ai < 2; ++ai)
#pragma unroll
            for (int m = 0; m < 4; ++m) tok[ai][m] = S.arow(u, ai * HALF + wr * 64 + m * 16 + fr);
#pragma unroll
        for (int ai = 0; ai < 2; ++ai)
#pragma unroll
            for (int m = 0; m < 4; ++m) sc[ai][m] = rstd[tok[ai][m]] * cs;
#pragma unroll
        for (int ai = 0; ai < 2; ++ai)
#pragma unroll
            for (int m = 0; m < 4; ++m) { const int rt = ai * HALF + wr * 64 + m * 16 + fr;
                unsigned char* rowp = O + (size_t)(u.pm * BM + rt) * DEXP + col0; float h[8];
#pragma unroll
                for (int n = 0; n < 2; ++n)
#pragma unroll
                    for (int k = 0; k < 4; ++k) { const float g = acc[ai][0][m][n][k] * sc[ai][m], up = acc[ai][1][m][n][k] * sc[ai][m]; h[n * 4 + k] = g / (1.0f + __expf(-g)) * up; }
                v2u w; w.x = pk_fp8x4(h[0], h[1], h[2], h[3]); w.y = pk_fp8x4(h[4], h[5], h[6], h[7]);
                *(v2u*)rowp = w; }
    }
};

template <class Epi, class Sched, bool ALIGN_EPI, bool GATHER, int FP8 = 0  >
__device__ __forceinline__ void gemm_phase(LAS unsigned char* lds, const Sched& S, const Epi& E, int wave) {
    int tid_ = wave * 64 + hw_lane(); asm volatile("" : "+v"(tid_));
    const int tid = tid_, wid = __builtin_amdgcn_readfirstlane(tid >> 6), lane = tid & 63, wr = wid >> 2, wc = wid & 3, fr = lane & 15, fq = lane >> 4;
    const int K = S.K, nt = K / BK;
    unsigned voffA[2], voffB[2]; int RA[2], CA[2];
#pragma unroll
    for (int i = 0; i < 2; ++i) { int R, C; stage_rc(tid * 16 + i * 8192, R, C); const int Rb = Epi::PERM ? ((R & ~31) + perm32(R & 31)) : R;
        RA[i] = R; CA[i] = C; voffA[i] = (unsigned)(R * K + C) * 2u; voffB[i] = (unsigned)(Rb * K + C) * 2u; }
    const size_t kstep = (size_t)(BK * 2);
    const size_t hstep = (size_t)HALF * K * 2;
    const unsigned ldsw = (unsigned)wid * 1024u;
    const int aoff = lds_byte(wr * 64 + fr, fq * 8), boff = lds_byte(wc * 32 + fr, fq * 8);
#define PG8_SA(b, h) (((b) * 2 + (h)) * HTB)
#define PG8_SB(b, h) ((4 + (b) * 2 + (h)) * HTB)
#define PG8_STAGE(bufoff, gbase, voff) do { _Pragma("unroll") for (int _i = 0; _i < 2; ++_i) \
        __builtin_amdgcn_global_load_lds((const unsigned*)((const char*)(gbase) + (voff)[_i]), (LAS unsigned*)(lds + (bufoff) + ldsw + _i * 8192), 16, 0, 0); } while (0)
#define PG8_STAGE_A(bufoff, h, gk, go) do { if constexpr (GATHER) { PG8_STAGE(bufoff, gk, (go)[h]); } else { PG8_STAGE(bufoff, (gk) + (h) * hstep, voffA); } } while (0)
#define PG8_LD8(off) __builtin_shufflevector(*(const LAS v4i_t*)(lds + (off)), *(const LAS v4i_t*)(lds + (off) + 1024), 0, 1, 2, 3, 4, 5, 6, 7)
#define PG8_LDA(dst, b, h) do { _Pragma("unroll") for (int m = 0; m < 4; ++m) dst[m] = PG8_LD8(PG8_SA(b, h) + aoff + m * 2048); } while (0)
#define PG8_LDB(dst, b, h) do { _Pragma("unroll") for (int n = 0; n < 2; ++n) dst[n] = PG8_LD8(PG8_SB(b, h) + boff + n * 2048); } while (0)
#define PG8_HALF(x, k) __builtin_bit_cast(bf16x8, __builtin_shufflevector(x, x, 4 * (k), 4 * (k) + 1, 4 * (k) + 2, 4 * (k) + 3))
#define PG8_MMA(ai, bj, At, Bt) do { if (PROBE_REP >= 0 && (pflags & 32768)) break; __builtin_amdgcn_s_setprio(1); _Pragma("unroll") for (int m = 0; m < 4; ++m) _Pragma("unroll") for (int n = 0; n < 2; ++n) { \
        if constexpr (FP8 == 2) { acc[ai][bj][m][n] = __builtin_bit_cast(f32x4, __builtin_amdgcn_mfma_i32_16x16x64_i8(__builtin_bit_cast(v4i_t, PG8_HALF(Bt[n], 0)), __builtin_bit_cast(v4i_t, PG8_HALF(At[m], 0)), __builtin_bit_cast(v4i_t, acc[ai][bj][m][n]), 0, 0, 0)); \
               acc[ai][bj][m][n] = __builtin_bit_cast(f32x4, __builtin_amdgcn_mfma_i32_16x16x64_i8(__builtin_bit_cast(v4i_t, PG8_HALF(Bt[n], 1)), __builtin_bit_cast(v4i_t, PG8_HALF(At[m], 1)), __builtin_bit_cast(v4i_t, acc[ai][bj][m][n]), 0, 0, 0)); } \
        else if constexpr (FP8 == 1) { asm volatile("v_mfma_scale_f32_16x16x128_f8f6f4 %0, %1, %2, %0, %3, %3 op_sel_hi:[0,0,0]" : "+v"(acc[ai][bj][m][n]) : "v"(Bt[n]), "v"(At[m]), "v"(sc1)); } \
        else { acc[ai][bj][m][n] = __builtin_amdgcn_mfma_f32_16x16x32_bf16(PG8_HALF(Bt[n], 0), PG8_HALF(At[m], 0), acc[ai][bj][m][n], 0, 0, 0); \
               acc[ai][bj][m][n] = __builtin_amdgcn_mfma_f32_16x16x32_bf16(PG8_HALF(Bt[n], 1), PG8_HALF(At[m], 1), acc[ai][bj][m][n], 0, 0, 0); } } \
        __builtin_amdgcn_s_setprio(0); } while (0)
#define PG8_WAIT_V(n) asm volatile("s_waitcnt vmcnt(" #n ")" ::: "memory")
#define PG8_WAIT_L(n) asm volatile("s_waitcnt lgkmcnt(" #n ")" ::: "memory")
#define PG8_BAR __builtin_amdgcn_s_barrier()
#define PG8_SCHED __builtin_amdgcn_sched_barrier(0)
#define PG8_GOFF(dst, u) do { if constexpr (GATHER) { _Pragma("unroll") for (int _h = 0; _h < 2; ++_h) _Pragma("unroll") for (int _i = 0; _i < 2; ++_i) \
        dst[_h][_i] = S.arow(u, _h * HALF + RA[_i]) * (unsigned)(K * 2) + (unsigned)(CA[_i] * 2); } } while (0)
    Unit cur, nxt; int ui = 0;
    if (!S.next(0, cur)) return;
    float zz = 0.f; asm volatile("" : "+v"(zz));
    f32x4 acc[2][2][4][2];
#pragma unroll
    for (int a = 0; a < 2; ++a)
#pragma unroll
        for (int b = 0; b < 2; ++b)
#pragma unroll
            for (int m = 0; m < 4; ++m)
#pragma unroll
                for (int n = 0; n < 2; ++n) acc[a][b][m][n] = (f32x4){zz, zz, zz, zz};
    int sc1 = 0x7f7f7f7f; asm volatile("" : "+v"(sc1));
    v8i_t At[4], B0[2], B1[2];
    unsigned cgo[2][2] = {{0u, 0u}, {0u, 0u}}, ngo[2][2] = {{0u, 0u}, {0u, 0u}};
    const int pflags = PROBE_REP >= 0 ? gemm_probe_flags() : 0;
    const char* cA = (pflags & 512) ? S.A : S.aptr(cur); const char* cB = (pflags & 512) ? S.Bt : S.bptr(cur);
    PG8_GOFF(cgo, cur);
    if constexpr (Epi::SCL) { cur.e = 0; E.stage(cur, wid); }
    PG8_STAGE(PG8_SB(0, 0), cB, voffB); PG8_STAGE(PG8_SB(0, 1), cB + hstep, voffB); PG8_STAGE_A(PG8_SA(0, 0), 0, cA, cgo); PG8_STAGE_A(PG8_SA(0, 1), 1, cA, cgo);
    if (wr == 1) PG8_BAR;
    PG8_WAIT_V(2); PG8_BAR;
    PG8_STAGE(PG8_SB(1, 0), cB + kstep, voffB); PG8_STAGE_A(PG8_SA(1, 0), 0, cA + kstep, cgo); PG8_STAGE(PG8_SB(1, 1), cB + hstep + kstep, voffB);
    PG8_WAIT_V(6); PG8_BAR;
    for (;;) {
        const bool has_next = S.next(ui + 1, nxt);
        if constexpr (Epi::SCL) nxt.e = (ui + 1) & 1;
        const char* nA = (has_next && !(pflags & 512)) ? S.aptr(nxt) : cA; const char* nB = (has_next && !(pflags & 512)) ? S.bptr(nxt) : cB;
        if constexpr (GATHER) { if (has_next) { PG8_GOFF(ngo, nxt); } else { ngo[0][0] = cgo[0][0]; ngo[0][1] = cgo[0][1]; ngo[1][0] = cgo[1][0]; ngo[1][1] = cgo[1][1]; } }
        for (int t = 0; t < nt; t += 2) {
            const bool last = (t == nt - 2);
            const char* a1 = cA + (size_t)(t + 1) * kstep;
            const char* a2 = last ? nA : cA + (size_t)(t + 2) * kstep; const char* b2 = last ? nB : cB + (size_t)(t + 2) * kstep;
            const char* a3 = a2 + kstep; const char* b3 = b2 + kstep;
            unsigned sgo[2][2];
            if constexpr (GATHER) { sgo[0][0] = last ? ngo[0][0] : cgo[0][0]; sgo[0][1] = last ? ngo[0][1] : cgo[0][1]; sgo[1][0] = last ? ngo[1][0] : cgo[1][0]; sgo[1][1] = last ? ngo[1][1] : cgo[1][1]; }
            PG8_LDB(B0, 0, 0); PG8_LDB(B1, 0, 1); PG8_SCHED; PG8_LDA(At, 0, 0); PG8_STAGE_A(PG8_SA(1, 1), 1, a1, cgo);
            PG8_WAIT_V(8); PG8_WAIT_L(0); PG8_BAR; PG8_MMA(0, 0, At, B0); PG8_MMA(0, 1, At, B1); PG8_BAR; PG8_SCHED;
            PG8_LDA(At, 0, 1); PG8_STAGE(PG8_SB(0, 0), b2, voffB); PG8_STAGE(PG8_SB(0, 1), b2 + hstep, voffB); PG8_STAGE_A(PG8_SA(0, 0), 0, a2, sgo);
            PG8_WAIT_V(8); PG8_WAIT_L(0); PG8_BAR; PG8_MMA(1, 0, At, B0); PG8_MMA(1, 1, At, B1); PG8_BAR; PG8_SCHED;
            PG8_LDB(B0, 1, 0); PG8_LDB(B1, 1, 1); PG8_SCHED; PG8_LDA(At, 1, 0); PG8_STAGE_A(PG8_SA(0, 1), 1, a2, sgo);
            PG8_WAIT_V(8); PG8_WAIT_L(0); PG8_BAR; PG8_MMA(0, 0, At, B0); PG8_MMA(0, 1, At, B1); PG8_BAR; PG8_SCHED;
            PG8_LDA(At, 1, 1); PG8_STAGE(PG8_SB(1, 0), b3, voffB); PG8_STAGE(PG8_SB(1, 1), b3 + hstep, voffB); PG8_STAGE_A(PG8_SA(1, 0), 0, a3, sgo);
            PG8_WAIT_V(8); PG8_WAIT_L(0); PG8_BAR; PG8_MMA(1, 0, At, B0); PG8_MMA(1, 1, At, B1); PG8_BAR; PG8_SCHED;
        }
        if constexpr (ALIGN_EPI) { if (wr == 0) PG8_BAR; }
        if constexpr (FP8 == 1) asm volatile("s_nop 15\n\ts_nop 15" ::: "memory");
        if (!(pflags & 256)) E(acc, cur, wr, wc, fr, fq);
        if (!has_next) break;
#pragma unroll
        for (int a = 0; a < 2; ++a)
#pragma unroll
            for (int b = 0; b < 2; ++b)
#pragma unroll
                for (int m = 0; m < 4; ++m)
#pragma unroll
                    for (int n = 0; n < 2; ++n) acc[a][b][m][n] = (f32x4){zz, zz, zz, zz};
        cur = nxt; cA = nA; cB = nB; ++ui;
        if constexpr (Epi::SCL) E.stage(cur, wid);
        if constexpr (GATHER) { cgo[0][0] = ngo[0][0]; cgo[0][1] = ngo[0][1]; cgo[1][0] = ngo[1][0]; cgo[1][1] = ngo[1][1]; }
        if constexpr (ALIGN_EPI) { if (wr == 1) PG8_BAR; }
    }
    PG8_WAIT_V(0);
    if constexpr (!ALIGN_EPI) { if (wr == 0) PG8_BAR; }
    PG8_BAR;
#undef PG8_SA
#undef PG8_SB
#undef PG8_STAGE
#undef PG8_STAGE_A
#undef PG8_LDA
#undef PG8_LDB
#undef PG8_MMA
#undef PG8_HALF
#undef PG8_LD8
#undef PG8_WAIT_V
#undef PG8_WAIT_L
#undef PG8_BAR
#undef PG8_SCHED
#undef PG8_GOFF
}
}

#include <hip/hip_bf16.h>
namespace attn_body {
using bf16=__hip_bfloat16;
using bf16x8=__attribute__((ext_vector_type(8)))short;
using s16x4=__attribute__((ext_vector_type(4)))short;
using f32x16=__attribute__((ext_vector_type(16)))float;
using u32x4=__attribute__((ext_vector_type(4)))unsigned;
constexpr int D=64,DM=5632;
constexpr int NW=8,QBLK=32,QB=QBLK*NW,KVBLK=64;
constexpr int ATTN_UNIT_ROWS=QB;
__device__ __forceinline__ int crow(int r,int hi){return (r&3)+8*(r>>2)+4*hi;}
#define SBAR() __builtin_amdgcn_sched_barrier(0)
__device__ __forceinline__ void cmask(f32x16&p0,f32x16&p1,int jb,int qrel,int hi){
  const float NEG=-INFINITY; int kb=64*jb+4*hi;
  #pragma unroll
  for(int r=0;r<16;++r){int kv=kb+(r&3)+8*(r>>2); if(kv>qrel)p0[r]=NEG; if(kv+32>qrel)p1[r]=NEG;}
}

constexpr int NSLOT=3, SLOTB=8192;
constexpr int LDS_K=0, LDS_V=NSLOT*SLOTB, LDS_WS=2*NSLOT*SLOTB, LDS_HOLD=LDS_WS+NW*64*4, LDS_BYTES=LDS_HOLD+NW*8192;
constexpr float C2=0.125f*1.4426950408889634f;
__device__ __forceinline__ void glds16(const void*gsrc,unsigned lds_dst){unsigned keep;
  asm volatile("s_mov_b32 %0, m0\n\ts_mov_b32 m0, %2\n\ts_nop 0\n\tglobal_load_lds_dwordx4 %1, off\n\ts_mov_b32 m0, %0":"=&s"(keep):"v"(gsrc),"s"(lds_dst):"memory");}
__device__ __forceinline__ float max3f(float a,float b,float c){float r;asm("v_max3_f32 %0, %1, %2, %3":"=v"(r):"v"(a),"v"(b),"v"(c));return r;}
__device__ __forceinline__ float max2f(float a,float b){float r;asm("v_max_f32_e32 %0, %1, %2":"=v"(r):"v"(a),"v"(b));return r;}
__device__ __forceinline__ float fadd_s(float a,float b){float r;asm("v_add_f32_e32 %0, %1, %2":"=v"(r):"v"(a),"v"(b));return r;}
__device__ __forceinline__ float fsub_s(float a,float b){float r;asm("v_sub_f32_e32 %0, %1, %2":"=v"(r):"v"(a),"v"(b));return r;}
typedef float f32x2_t __attribute__((ext_vector_type(2))); typedef __bf16 bf16x2_t __attribute__((ext_vector_type(2)));
__device__ __forceinline__ unsigned cvtpk_s(float lo,float hi){f32x2_t v={lo,hi};bf16x2_t b=__builtin_convertvector(v,bf16x2_t);return __builtin_bit_cast(unsigned,b);}
#define WAIT_BAR(N) asm volatile("s_waitcnt vmcnt(" #N ") lgkmcnt(0)\n\ts_barrier":::"memory")

__device__ __forceinline__ void qkt(f32x16&p0,f32x16&p1,const char*Kslot,const bf16x8*qr,const f32x16&negm,int r32,int hi){
  const char*kb=Kslot+hi*1024+r32*16;
  #pragma unroll
  for(int d0=0;d0<4;++d0){
    const bf16x8 b0=*reinterpret_cast<const bf16x8*>(kb+d0*2048);
    const bf16x8 b1=*reinterpret_cast<const bf16x8*>(kb+d0*2048+512);
    if(d0==0){p0=__builtin_amdgcn_mfma_f32_32x32x16_bf16(b0,qr[0],negm,0,0,0);p1=__builtin_amdgcn_mfma_f32_32x32x16_bf16(b1,qr[0],negm,0,0,0);}
    else{p0=__builtin_amdgcn_mfma_f32_32x32x16_bf16(b0,qr[d0],p0,0,0,0);p1=__builtin_amdgcn_mfma_f32_32x32x16_bf16(b1,qr[d0],p1,0,0,0);}}
}
typedef __attribute__((address_space(3))) const char* lds_cptr;
typedef short v4i16_t __attribute__((ext_vector_type(4)));
__device__ __forceinline__ void kload8(bf16x8*kf,lds_cptr kp){
  kf[0]=*(const __attribute__((address_space(3))) bf16x8*)(kp);      kf[1]=*(const __attribute__((address_space(3))) bf16x8*)(kp+512);
  kf[2]=*(const __attribute__((address_space(3))) bf16x8*)(kp+2048); kf[3]=*(const __attribute__((address_space(3))) bf16x8*)(kp+2560);
  kf[4]=*(const __attribute__((address_space(3))) bf16x8*)(kp+4096); kf[5]=*(const __attribute__((address_space(3))) bf16x8*)(kp+4608);
  kf[6]=*(const __attribute__((address_space(3))) bf16x8*)(kp+6144); kf[7]=*(const __attribute__((address_space(3))) bf16x8*)(kp+6656);
}
__device__ __forceinline__ void kload2(bf16x8*kf,lds_cptr kp,int j){ kf[2*j]=*(const __attribute__((address_space(3))) bf16x8*)(kp+j*2048); kf[2*j+1]=*(const __attribute__((address_space(3))) bf16x8*)(kp+j*2048+512); }
__device__ __forceinline__ s16x4 vtr(lds_cptr p){ return __builtin_bit_cast(s16x4,__builtin_amdgcn_ds_read_tr16_b64_v4i16((__attribute__((address_space(3))) v4i16_t*)p)); }
__device__ __forceinline__ float rowmax(const f32x16&p0,const f32x16&p1){
  float a=max3f(p0[0],p0[1],p1[0]),b=max3f(p0[2],p0[3],p1[1]);a=max3f(a,p1[2],p1[3]);
  #pragma unroll
  for(int r=4;r<16;r+=4){a=max3f(a,p0[r],p0[r+1]);b=max3f(b,p0[r+2],p0[r+3]);a=max3f(a,p1[r],p1[r+1]);b=max3f(b,p1[r+2],p1[r+3]);}
  const float m=max2f(a,b);
  auto rr=__builtin_amdgcn_permlane32_swap(__float_as_uint(m),__float_as_uint(m),false,false);
  return max2f(__uint_as_float(rr[0]),__uint_as_float(rr[1]));
}
__device__ __forceinline__ void pv(f32x16*o,int vb,bf16x8 pa0,bf16x8 pa1,bf16x8 pa2,bf16x8 pa3){
  #pragma unroll
  for(int d0=0;d0<2;++d0){s16x4 lo[4],hi[4];
    #pragma unroll
    for(int ks=0;ks<4;++ks){
      asm volatile("ds_read_b64_tr_b16 %0,%1 offset:%c2":"=&v"(lo[ks]):"v"(vb),"i"(d0*4096+ks*1024):"memory");
      asm volatile("ds_read_b64_tr_b16 %0,%1 offset:%c2":"=&v"(hi[ks]):"v"(vb),"i"(d0*4096+ks*1024+512):"memory");}
    asm volatile("s_waitcnt lgkmcnt(0)":::"memory");SBAR();
    #define PK(k) (bf16x8){lo[k][0],lo[k][1],lo[k][2],lo[k][3],hi[k][0],hi[k][1],hi[k][2],hi[k][3]}
    o[d0]=__builtin_amdgcn_mfma_f32_32x32x16_bf16(pa0,PK(0),o[d0],0,0,0);
    o[d0]=__builtin_amdgcn_mfma_f32_32x32x16_bf16(pa1,PK(1),o[d0],0,0,0);
    o[d0]=__builtin_amdgcn_mfma_f32_32x32x16_bf16(pa2,PK(2),o[d0],0,0,0);
    o[d0]=__builtin_amdgcn_mfma_f32_32x32x16_bf16(pa3,PK(3),o[d0],0,0,0);
    #undef PK
  }
}

#ifndef ATTN_STORE16
#define ATTN_STORE16(p,v) (*(u32x4*)(p)=(v))
#endif
template<int THRL> __device__ __forceinline__ void attn_run(const bf16*Qw0,const bf16*__restrict__ Kh,const bf16*__restrict__ Vh,int q0,char*shm,int mode,int fcol,float lam,int wave){
  int tid_=wave*64+hw_lane(); asm volatile("":"+v"(tid_));
  const int tid=tid_,lane=tid&63,r32=lane&31,hi=lane>>5; const int wid=__builtin_amdgcn_readfirstlane(tid>>6);

  const bf16*Qw=Qw0+(long)(wid*QBLK)*DM;

  const unsigned lds0=(unsigned)(uintptr_t)shm;
  float*wsf=(float*)(shm+LDS_WS)+wid*64;
  const bf16*ksrc=Kh+(long)lane*DM+wid*8;
  const bf16*vsrc=Vh+(long)(16*(wid&3)+(lane>>2))*DM+(wid>>2)*32+(lane&3)*8;
  const unsigned kdst=lds0+LDS_K+wid*1024, vdst=lds0+LDS_V+wid*1024;
  #define DMA_K(t,slot) glds16(ksrc+(long)(t)*KVBLK*DM,(unsigned)__builtin_amdgcn_readfirstlane(kdst+(slot)))
  #define DMA_V(t,slot) glds16(vsrc+(long)(t)*KVBLK*DM,(unsigned)__builtin_amdgcn_readfirstlane(vdst+(slot)))
  const int vb0=(int)(lds0+LDS_V)+((lane>>4)&1)*32+(lane&3)*8+(4*hi+((lane&15)>>2))*64;
  const char*Kbase=shm+LDS_K; bf16x8 kf[8];
  const lds_cptr shm3=(lds_cptr)shm; const lds_cptr kp0=shm3+LDS_K+hi*1024+r32*16; const lds_cptr vp0=shm3+LDS_V+((lane>>4)&1)*32+(lane&3)*8+(4*hi+((lane&15)>>2))*64;
  const int NT=(q0+QB)/KVBLK;
  DMA_K(0,0);DMA_V(0,0);DMA_K(1,SLOTB);
  bf16x8 qr[4];
  #pragma unroll
  for(int d0=0;d0<4;++d0)qr[d0]=*reinterpret_cast<const bf16x8*>(&Qw[(long)r32*DM+d0*16+hi*8]);
  float mhat=0.f,l_reg=0.f;f32x16 o[2];o[0]=f32x16{};o[1]=f32x16{};const f32x16 negm=f32x16{};
  const int qrel=wid*QBLK+r32;
  #define CMASK(P0,P1,t) do{int jb_=(t)-(NT-4); if(jb_>=0)cmask(P0,P1,jb_,qrel,hi);}while(0)
  bool resc=false;
  #define START(P0,P1) do{ const float rm=rowmax(P0,P1); resc=false; \
    { const float dl=rm; mhat=fadd_s(mhat,dl); \
      _Pragma("unroll") for(int r=0;r<16;++r){P0[r]=fsub_s(P0[r],dl);P1[r]=fsub_s(P1[r],dl);} \
      } \
    _Pragma("unroll") for(int r=0;r<16;++r)P0[r]=__builtin_amdgcn_exp2f(P0[r]); }while(0)
  #define RESC() do{ if(resc){ asm volatile("s_waitcnt lgkmcnt(0)":::"memory"); \
      _Pragma("unroll") for(int d_=0;d_<2;++d_) _Pragma("unroll") for(int r=0;r<16;++r)o[d_][r]*=wsf[crow(r,hi)]; } }while(0)
  f32x16 pA0,pA1,pB0,pB1;
  int sl_prev=0,sl_cur=0,sl_next=SLOTB;
  #define ROT() do{sl_prev=sl_cur;sl_cur=sl_next;sl_next=(sl_next==(NSLOT-1)*SLOTB)?0:sl_next+SLOTB;}while(0)
  DMA_K(2,2*SLOTB);
  WAIT_BAR(3);
  qkt(pA0,pA1,Kbase,qr,negm,r32,hi);asm volatile("s_nop 15\n\ts_nop 7":"+v"(pA0),"+v"(pA1));CMASK(pA0,pA1,0);
  START(pA0,pA1);
  _Pragma("unroll") for(int r=0;r<16;++r)pA1[r]=__builtin_amdgcn_exp2f(pA1[r]);
  WAIT_BAR(0);
  DMA_K(3,0);DMA_V(1,SLOTB);
  ROT();
  kload8(kf,kp0+sl_cur);
  WAIT_BAR(2);
  s16x4 vlo[8],vhi[8]; u32x4 pw0,pw1,pw2,pw3;
  #define PKW(P,B) cvtpk_s(P[B],P[B+1])
  #define PAF(k) __builtin_bit_cast(bf16x8,pw##k)
  #define VFR(i) (bf16x8){vlo[i][0],vlo[i][1],vlo[i][2],vlo[i][3],vhi[i][0],vhi[i][1],vhi[i][2],vhi[i][3]}
  #define PIN(x) asm volatile("":"+v"(x))
  #define MX3(a,b,c) __builtin_fmaxf(__builtin_fmaxf((a),(b)),(c))
  #define GAPA(MF,A0,A1,A2,A3,W0,W1,PW) do{ MF; sacc+=A0; sacc+=A1; sacc+=A2; sacc+=A3; PIN(sacc); W0; W1; PIN(PW); SBAR(); }while(0)
  #define EX(v) __builtin_amdgcn_exp2f(v)
  #define GAPB(MF,X,B) do{ MF; X[B]=EX(X[B]); X[B+1]=EX(X[B+1]); X[B+2]=EX(X[B+2]); X[B+3]=EX(X[B+3]); PIN(X); SBAR(); }while(0)
  #define VRD(i) do{ vlo[i]=vtr(vp_+(((i)>>2)*4096+((i)&3)*1024)); vhi[i]=vtr(vp_+(((i)>>2)*4096+((i)&3)*1024+512)); }while(0)
  #define KRD(G,j) do{ if(G){ kload2(kf,kp0+sl_next,j); SBAR(); } }while(0)
  #define STEP(C0,C1,P0,P1,t,GK,GV,GL) do{ SBAR(); \
    const lds_cptr vp_=vp0+sl_prev; \
    VRD(0); SBAR(); float sacc=(P0[0]+P0[1]); \
    GAPA(C0=__builtin_amdgcn_mfma_f32_32x32x16_bf16(kf[0],qr[0],negm,0,0,0), P0[2],P0[3],P0[4],P0[5],     pw0[0]=PKW(P0,0), pw0[1]=PKW(P0,2), pw0); \
    VRD(4); SBAR(); GAPA(C1=__builtin_amdgcn_mfma_f32_32x32x16_bf16(kf[1],qr[0],negm,0,0,0), P0[6],P0[7],P0[8],P0[9],     pw0[2]=PKW(P0,4), pw0[3]=PKW(P0,6), pw0); \
    VRD(1); SBAR(); GAPA(C0=__builtin_amdgcn_mfma_f32_32x32x16_bf16(kf[2],qr[1],C0,0,0,0),   P0[10],P0[11],P0[12],P0[13], pw1[0]=PKW(P0,8), pw1[1]=PKW(P0,10), pw1); \
    VRD(5); SBAR(); GAPA(C1=__builtin_amdgcn_mfma_f32_32x32x16_bf16(kf[3],qr[1],C1,0,0,0),   P0[14],P0[15],P1[0],P1[1],   pw1[2]=PKW(P0,12),pw1[3]=PKW(P0,14), pw1); \
    VRD(2); SBAR(); GAPA(C0=__builtin_amdgcn_mfma_f32_32x32x16_bf16(kf[4],qr[2],C0,0,0,0),   P1[2],P1[3],P1[4],P1[5],     pw2[0]=PKW(P1,0), pw2[1]=PKW(P1,2), pw2); \
    VRD(6); SBAR(); GAPA(C1=__builtin_amdgcn_mfma_f32_32x32x16_bf16(kf[5],qr[2],C1,0,0,0),   P1[6],P1[7],P1[8],P1[9],     pw2[2]=PKW(P1,4), pw2[3]=PKW(P1,6), pw2); \
    VRD(3); SBAR(); GAPA(C0=__builtin_amdgcn_mfma_f32_32x32x16_bf16(kf[6],qr[3],C0,0,0,0),   P1[10],P1[11],P1[12],P1[13], pw3[0]=PKW(P1,8), pw3[1]=PKW(P1,10), pw3); \
    VRD(7); SBAR(); GAPA(C1=__builtin_amdgcn_mfma_f32_32x32x16_bf16(kf[7],qr[3],C1,0,0,0),   P1[14],P1[15],0.f,0.f,       pw3[2]=PKW(P1,12),pw3[3]=PKW(P1,14), pw3); \
    l_reg+=sacc; \
    if(GK){DMA_K((t)+3,sl_cur);} if(GV){DMA_V((t)+1,sl_next);} \
    _Pragma("unroll") for(int r=0;r<16;++r){C0[r]-=mhat;C1[r]-=mhat;} \
    CMASK(C0,C1,t); \
    { float a=MX3(C0[0],C0[1],C1[0]),b=MX3(C0[2],C0[3],C1[1]); a=MX3(a,C1[2],C1[3]); \
      _Pragma("unroll") for(int r=4;r<16;r+=4){a=MX3(a,C0[r],C0[r+1]);b=MX3(b,C0[r+2],C0[r+3]);a=MX3(a,C1[r],C1[r+1]);b=MX3(b,C1[r+2],C1[r+3]);} \
      float rm=__builtin_fmaxf(a,b); { auto rr=__builtin_amdgcn_permlane32_swap(__float_as_uint(rm),__float_as_uint(rm),false,false); rm=__builtin_fmaxf(__uint_as_float(rr[0]),__uint_as_float(rr[1])); } \
      resc=false; \
      if(__builtin_expect(__any(rm>(float)THRL),0)){ const float dl=__builtin_fmaxf(rm,0.f); mhat+=dl; \
        _Pragma("unroll") for(int r=0;r<16;++r){C0[r]-=dl;C1[r]-=dl;} \
        const float f=__builtin_amdgcn_exp2f(-dl); l_reg*=f; if(hi==0)wsf[r32]=f; resc=true; } } \
    SBAR(); \
    GAPB(o[0]=__builtin_amdgcn_mfma_f32_32x32x16_bf16(PAF(0),VFR(0),o[0],0,0,0), C0,0); \
    GAPB(o[1]=__builtin_amdgcn_mfma_f32_32x32x16_bf16(PAF(0),VFR(4),o[1],0,0,0), C0,4); \
    KRD(GL,0); GAPB(o[0]=__builtin_amdgcn_mfma_f32_32x32x16_bf16(PAF(1),VFR(1),o[0],0,0,0), C0,8); \
    KRD(GL,1); GAPB(o[1]=__builtin_amdgcn_mfma_f32_32x32x16_bf16(PAF(1),VFR(5),o[1],0,0,0), C0,12); \
    KRD(GL,2); GAPB(o[0]=__builtin_amdgcn_mfma_f32_32x32x16_bf16(PAF(2),VFR(2),o[0],0,0,0), C1,0); \
    KRD(GL,3); GAPB(o[1]=__builtin_amdgcn_mfma_f32_32x32x16_bf16(PAF(2),VFR(6),o[1],0,0,0), C1,4); \
    GAPB(o[0]=__builtin_amdgcn_mfma_f32_32x32x16_bf16(PAF(3),VFR(3),o[0],0,0,0), C1,8); \
    GAPB(o[1]=__builtin_amdgcn_mfma_f32_32x32x16_bf16(PAF(3),VFR(7),o[1],0,0,0), C1,12); \
    }while(0)
  int t=1;
  #undef CMASK
  #define CMASK(P0,P1,t) do{}while(0)
  for(;t+5<NT;t+=2){
    STEP(pB0,pB1,pA0,pA1,t,true,true,true);     WAIT_BAR(2); RESC(); ROT();
    STEP(pA0,pA1,pB0,pB1,t+1,true,true,true);   WAIT_BAR(2); RESC(); ROT();
  }
  #undef CMASK
  #define CMASK(P0,P1,t) do{int jb_=(t)-(NT-4); if(jb_>=0)cmask(P0,P1,jb_,qrel,hi);}while(0)
  #define ENDW(tt) do{ if((tt)+3<NT){WAIT_BAR(2);} else if((tt)+2<NT){WAIT_BAR(1);} else {WAIT_BAR(0);} }while(0)
  for(;t+1<NT;t+=2){
    STEP(pB0,pB1,pA0,pA1,t,(t+3<NT),(t+1<NT),(t+1<NT));       ENDW(t);   RESC(); ROT();
    STEP(pA0,pA1,pB0,pB1,t+1,(t+4<NT),(t+2<NT),(t+2<NT));     ENDW(t+1); RESC(); ROT();
  }
  STEP(pB0,pB1,pA0,pA1,NT-1,false,false,false); RESC();
  { float sacc=pB0[0]+pB0[1]; _Pragma("unroll") for(int r=2;r<16;++r)sacc+=pB0[r]; _Pragma("unroll") for(int r=0;r<16;++r)sacc+=pB1[r]; l_reg+=sacc;
    pw0=(u32x4){PKW(pB0,0),PKW(pB0,2),PKW(pB0,4),PKW(pB0,6)};pw1=(u32x4){PKW(pB0,8),PKW(pB0,10),PKW(pB0,12),PKW(pB0,14)};pw2=(u32x4){PKW(pB1,0),PKW(pB1,2),PKW(pB1,4),PKW(pB1,6)};pw3=(u32x4){PKW(pB1,8),PKW(pB1,10),PKW(pB1,12),PKW(pB1,14)};
    SBAR(); pv(o,vb0+sl_cur,PAF(0),PAF(1),PAF(2),PAF(3)); }
  #undef PKW
  #undef PAF
  #undef VFR
  #undef PIN
  #undef MX3
  #undef GAPA
  #undef GAPB
  #undef EX
  #undef VRD
  #undef KRD
  #undef STEP
  #undef ENDW
  {auto rr=__builtin_amdgcn_permlane32_swap(__float_as_uint(l_reg),__float_as_uint(l_reg),false,false);l_reg=__uint_as_float(rr[0])+__uint_as_float(rr[1]);}
  if(hi==0)wsf[32+r32]=l_reg;asm volatile("s_waitcnt lgkmcnt(0)":::"memory");
  float rli[16];
  #pragma unroll
  for(int r=0;r<16;++r)rli[r]=__builtin_amdgcn_rcpf(wsf[32+crow(r,hi)]);
  { bf16*hold=(bf16*)(shm+LDS_HOLD)+wid*4096;
    #pragma unroll
    for(int r=0;r<16;++r){const int orow=crow(r,hi);
      #pragma unroll
      for(int d0=0;d0<2;++d0){ bf16*hp=hold+orow*128+fcol+d0*32+r32; float v=o[d0][r]*rli[r];
        if(mode){ v=__bfloat162float(*hp)-lam*v; } *hp=__float2bfloat16(v);} }
    asm volatile("s_waitcnt lgkmcnt(0)":::"memory"); }
  asm volatile("s_waitcnt lgkmcnt(0)\n\ts_barrier":::"memory");
  #undef DMA_K
  #undef DMA_V
  #undef CMASK
  #undef START
  #undef RESC
  #undef ROT
}
#undef SBAR
#undef WAIT_BAR
}

struct Args { const float* in[24]; float* out; unsigned char* ws; int ph_lo, ph_hi, flags, pad; };
typedef __attribute__((address_space(4))) const char kchar;
__device__ __forceinline__ kchar* karg_base() { kchar* p = (kchar*)__builtin_amdgcn_kernarg_segment_ptr(); asm volatile("" : "+s"(p)); return p; }
__device__ __forceinline__ const float* karg_in(int i) { typedef const float* fp; return *(__attribute__((address_space(4))) const fp*)(karg_base() + 8 * i); }
__device__ __forceinline__ float* karg_out() { typedef float* fp; return *(__attribute__((address_space(4))) const fp*)(karg_base() + 192); }
__device__ __forceinline__ unsigned char* karg_ws() { typedef unsigned char* up; return *(__attribute__((address_space(4))) const up*)(karg_base() + 200); }
__device__ __forceinline__ int karg_int(int off) { return *(__attribute__((address_space(4))) const int*)(karg_base() + off); }
__device__ __forceinline__ int karg_flags() { return karg_int(216); }
static_assert(sizeof(Args) == 224, "kernarg layout: in[24] @0, out @192, ws @200, ph_lo @208, ph_hi @212, flags @216, pad @220");
__device__ __forceinline__ int gemm_probe_flags() { return karg_flags(); }
enum { I_X = 0, I_N1G, I_WIN, I_GMVG, I_GMWS, I_GMB, I_CONVW, I_CONVB, I_IGB, I_FGB, I_MLNG, I_QNG, I_KNG, I_LAM, I_SUBG, I_WOUT, I_N2G, I_WRG, I_BRG, I_WRE, I_BRE, I_WG, I_WU, I_WD };

__device__ __forceinline__ s16x4 tr16(const LAS bf16* p) { return __builtin_bit_cast(s16x4, __builtin_amdgcn_ds_read_tr16_b64_v4i16((LAS s16x4*)p)); }
__device__ __forceinline__ int crow(int r, int hi) { return (r & 3) + 8 * (r >> 2) + 4 * hi; }
#define MFMA32(a, b, c) __builtin_amdgcn_mfma_f32_32x32x16_bf16((a), (b), (c), 0, 0, 0)
#define MFMA16(a, b, c) __builtin_amdgcn_mfma_f32_16x16x32_bf16((a), (b), (c), 0, 0, 0)
__device__ __forceinline__ bf16x8 mk8(s16x4 lo, s16x4 hi) { return (bf16x8){lo[0], lo[1], lo[2], lo[3], hi[0], hi[1], hi[2], hi[3]}; }
__device__ __forceinline__ void unpack8(const v4u w, float (&x)[8]) { x[0] = lo_f(w.x); x[1] = hi_f(w.x); x[2] = lo_f(w.y); x[3] = hi_f(w.y); x[4] = lo_f(w.z); x[5] = hi_f(w.z); x[6] = lo_f(w.w); x[7] = hi_f(w.w); }
__device__ __forceinline__ v4u pack8(const float (&x)[8]) { v4u w; w.x = pk2(x[0], x[1]); w.y = pk2(x[2], x[3]); w.z = pk2(x[4], x[5]); w.w = pk2(x[6], x[7]); return w; }

__device__ __forceinline__ void tr_tile(const float* W, int ldw, int k0, int nsrc0, bf16* WT, int Kdst, int ndst0, LAS float* scr, int lane) {
#pragma unroll
    for (int i = 0; i < 16; ++i) {
        const int kk = 4 * i + (lane >> 4);
        const f32x4 v = *(const GAS f32x4*)(W + (size_t)(k0 + kk) * ldw + nsrc0 + 4 * (lane & 15));
        LAS float* d = scr + kk * 65 + 4 * (lane & 15);
        d[0] = v.x; d[1] = v.y; d[2] = v.z; d[3] = v.w;
    }
    LDS_WAIT(); asm volatile("" ::: "memory");
#pragma unroll
    for (int j = 0; j < 8; ++j) {
        const int n = 8 * j + (lane >> 3), c = lane & 7;
        const LAS float* s = scr + (8 * c) * 65 + n;
        v4u o; o.x = pk2(s[0 * 65], s[1 * 65]); o.y = pk2(s[2 * 65], s[3 * 65]); o.z = pk2(s[4 * 65], s[5 * 65]); o.w = pk2(s[6 * 65], s[7 * 65]);
        *(GAS v4u*)(WT + (size_t)(ndst0 + n) * Kdst + k0 + 8 * c) = o;
    }
    LDS_WAIT(); asm volatile("" ::: "memory");
}
__device__ __forceinline__ void tr8_load(f32x4 (&v)[16], const float* W, int ldw, int k0, int nsrc0, int lane) {
#pragma unroll
    for (int i = 0; i < 16; ++i) v[i] = *(const GAS f32x4*)(W + (size_t)(k0 + 4 * i + (lane >> 4)) * ldw + nsrc0 + 4 * (lane & 15));
}
__device__ __forceinline__ void tr8_finish(const f32x4 (&v)[16], int k0, unsigned char* WT8, int Kdst, int ndst0, float scale, LAS float* scr, int lane) {
#pragma unroll
    for (int i = 0; i < 16; ++i) { LAS float* d = scr + (4 * i + (lane >> 4)) * 65 + 4 * (lane & 15);
        d[0] = v[i].x * scale; d[1] = v[i].y * scale; d[2] = v[i].z * scale; d[3] = v[i].w * scale; }
    LDS_WAIT(); asm volatile("" ::: "memory");
#pragma unroll
    for (int j = 0; j < 4; ++j) {
        const int n = 16 * j + (lane >> 2), c = lane & 3;
        const LAS float* s = scr + (16 * c) * 65 + n;
        v4u o; o.x = pk_fp8x4(s[0 * 65], s[1 * 65], s[2 * 65], s[3 * 65]); o.y = pk_fp8x4(s[4 * 65], s[5 * 65], s[6 * 65], s[7 * 65]);
        o.z = pk_fp8x4(s[8 * 65], s[9 * 65], s[10 * 65], s[11 * 65]); o.w = pk_fp8x4(s[12 * 65], s[13 * 65], s[14 * 65], s[15 * 65]);
        *(GAS v4u*)(WT8 + (size_t)(ndst0 + n) * Kdst + k0 + 16 * c) = o;
    }
    LDS_WAIT(); asm volatile("" ::: "memory");
}
__device__ __forceinline__ void tr_tile_fp8(const float* W, int ldw, int k0, int nsrc0, unsigned char* WT8, int Kdst, int ndst0, float scale, LAS float* scr, int lane) {
    f32x4 v[16]; tr8_load(v, W, ldw, k0, nsrc0, lane); tr8_finish(v, k0, WT8, Kdst, ndst0, scale, scr, lane);
}
__device__ __forceinline__ void conv_phase(const Args& a, LAS unsigned char* lds, int gw, int NGW, int wave, int lane) {
    LAS float* scr = (LAS float*)(lds + wave * 16640);
    unsigned char* ws = karg_ws();
    constexpr int T_IN1 = 32 * 52, T_IN2 = 32 * 36, T_OUT = 32 * 32, T_L = T_IN1 + T_IN2 + T_OUT;
    for (int it = gw; it < 2 * T_L; it += NGW) {
        const int l = it / T_L; int r = it % T_L;
        if (G1_I8 && r < T_IN1 + T_IN2) continue;
        const float* w_in = karg_in(I_WIN) + (size_t)l * DMODEL * DIN; const float* w_out = karg_in(I_WOUT) + (size_t)l * 2048 * 2048;
        bf16* WIN_T = (bf16*)(ws + (l ? WS_WIN1 : WS_WIN)); bf16* WOUT_T = (bf16*)(ws + (l ? WS_WOUT1 : WS_WOUT));
        unsigned char* WIN8 = ws + WS_WIN8 + (size_t)l * 11 * MiB;
        if (r < T_IN1) { const int kb = r / 52, nb = r % 52; tr_tile(w_in, DIN, 64 * kb, 64 * nb, WIN_T, 2048, 64 * nb, scr, lane); if (G1_SPLIT) tr_tile_fp8(w_in, DIN, 64 * kb, 64 * nb, WIN8, 2048, 64 * nb, SC_WIN, scr, lane); continue; } r -= T_IN1;
        if (r < T_IN2) { const int kb = r / 36, nb = r % 36; tr_tile(w_in, DIN, 64 * kb, 3340 + 64 * nb, WIN_T, 2048, 3328 + 64 * nb, scr, lane); if (G1_SPLIT) tr_tile_fp8(w_in, DIN, 64 * kb, 3340 + 64 * nb, WIN8, 2048, 3328 + 64 * nb, SC_WIN, scr, lane); continue; } r -= T_IN2;
        { const int kb = r / 32, nb = r % 32; tr_tile(w_out, 2048, 64 * kb, 64 * nb, WOUT_T, 2048, 64 * nb, scr, lane); }
    }
    if (G1_I8) {
        unsigned* cm = (unsigned*)(ws + WS_CTL) + CW_CMAX;
        for (int j = gw; j < 2 * 88 * 8; j += NGW) {
            const int lj = j / 704, r = j % 704, strip = r >> 3, kc = r & 7, c4 = lane & 15, kq = lane >> 4;
            const int pc = 64 * strip + 4 * c4, sc_ = pc < 3328 ? pc : pc + 12;
            const float* wp = karg_in(I_WIN) + (size_t)lj * DMODEL * DIN + (size_t)(256 * kc + kq) * DIN + sc_;
            f32x4 mx = {0.f, 0.f, 0.f, 0.f};
#pragma unroll 32
            for (int i = 0; i < 64; ++i) { const f32x4 v = *(const GAS f32x4*)(wp + (size_t)(4 * i) * DIN); mx.x = fmaxf(mx.x, fabsf(v.x)); mx.y = fmaxf(mx.y, fabsf(v.y)); mx.z = fmaxf(mx.z, fabsf(v.z)); mx.w = fmaxf(mx.w, fabsf(v.w)); }
#pragma unroll
            for (int o = 16; o < 64; o <<= 1) { mx.x = fmaxf(mx.x, sx(mx.x, o)); mx.y = fmaxf(mx.y, sx(mx.y, o)); mx.z = fmaxf(mx.z, sx(mx.z, o)); mx.w = fmaxf(mx.w, sx(mx.w, o)); }
            if (kq == 0) { unsigned* d = cm + 8192 * lj + pc; atomicMax(d, __float_as_uint(mx.x)); atomicMax(d + 1, __float_as_uint(mx.y)); atomicMax(d + 2, __float_as_uint(mx.z)); atomicMax(d + 3, __float_as_uint(mx.w)); }
        }
    }
    const int l = 0;
    if (l == 0) {
        const float invf[8] = {1.0f, 0.19392274474868576f, 0.03760603093086393f, 0.007292664737217109f, 0.001414213562373095f, 0.0002742481756762073f, 5.318295896944988e-05f, 1.031338537721246e-05f};
        float* rope = (float*)(ws + WS_ROPE);
        for (int i = gw * 64 + lane; i < SEQ * 8; i += NGW * 64) { const int pos = i >> 3, j = i & 7; float f = invf[0];
#pragma unroll
            for (int q = 1; q < 8; ++q) f = (j == q) ? invf[q] : f;
            const float ang = (float)pos * f; rope[pos * 16 + j] = cosf(ang); rope[pos * 16 + 8 + j] = sinf(ang); }
    }
    for (int i2 = gw * 64 + lane; i2 < 2 * (8192 + 24576); i2 += NGW * 64) {
        const int lf = i2 / (8192 + 24576), i = i2 % (8192 + 24576);
        const float* w_in = karg_in(I_WIN) + (size_t)lf * DMODEL * DIN; const float* w_rg = karg_in(I_WRG) + (size_t)lf * 2048 * 4; const float* w_re = karg_in(I_WRE) + (size_t)lf * 2048 * 32;
        v4u* RWG = (v4u*)(ws + WS_RWG + lf * RW_LSTRIDE); v4u* RWR = (v4u*)(ws + WS_RWR + lf * RW_LSTRIDE);
        const bool isg = i < 8192; const int ii = isg ? i : i - 8192;
        const int ln = ii & 63, ks = (ii >> 6) & 63, rest = ii >> 12;
        const int hl = isg ? rest : rest / 3, nt = isg ? 0 : rest % 3;
        const int n = ln & 15, q = ln >> 4, c = 16 * nt + n; float w[8];
        const bool valid = isg ? (c < 12) : (c < 36);
        const float* src = isg ? (w_in + SRC_GATE + (valid ? c : 0)) : (c < 4 ? (w_rg + c) : (w_re + (valid ? c - 4 : 0)));
        const size_t stride = isg ? (size_t)DIN : (c < 4 ? (size_t)4 : (size_t)32);
        float raw[8];
#pragma unroll
        for (int j = 0; j < 8; ++j) raw[j] = src[(size_t)(32 * ks + 8 * q + j) * stride];
#pragma unroll
        for (int j = 0; j < 8; ++j) { const float v = valid ? raw[j] : 0.f;
            const float h = bf2f(f2bf(v)); w[j] = hl ? (v - h) : h; }
        const v4u o = pack8(w);
        if (isg) RWG[ii] = o; else RWR[ii] = o;
    }
}

__device__ __forceinline__ void quant_win_phase(LAS unsigned char* lds, int gw, int NGW, int wave, int lane) {
    LAS float* scr = (LAS float*)(lds + wave * 16640);
    unsigned char* ws = karg_ws(); const unsigned* cm = (const unsigned*)(ws + WS_CTL) + CW_CMAX;
    for (int it = gw; it < 2 * 32 * 88; it += NGW) {
        const int lq = it / 2816, r = it % 2816, kb = r / 88, nb = r % 88, k0 = 64 * kb, n0 = 64 * nb, sn0 = n0 < 3328 ? n0 : n0 + 12;
        const float* W = karg_in(I_WIN) + (size_t)lq * DMODEL * DIN; signed char* Q = (signed char*)(ws + WS_WIN8 + (size_t)lq * 11 * MiB);
#pragma unroll
        for (int i = 0; i < 16; ++i) { const int kk = 4 * i + (lane >> 4);
            const f32x4 v = *(const GAS f32x4*)(W + (size_t)(k0 + kk) * DIN + sn0 + 4 * (lane & 15));
            LAS float* d = scr + kk * 65 + 4 * (lane & 15); d[0] = v.x; d[1] = v.y; d[2] = v.z; d[3] = v.w; }
        LDS_WAIT(); asm volatile("" ::: "memory");
#pragma unroll
        for (int j = 0; j < 4; ++j) {
            const int n = 16 * j + (lane >> 2), c = lane & 3;
            const float cmx = __uint_as_float(cm[8192 * lq + n0 + n]), inv = cmx > 0.f ? 127.0f / cmx : 0.f;
            const LAS float* sp = scr + (16 * c) * 65 + n; unsigned w[4];
#pragma unroll
            for (int d4 = 0; d4 < 4; ++d4) { unsigned pk = 0u;
#pragma unroll
                for (int e = 0; e < 4; ++e) pk |= ((unsigned)(int)__builtin_rintf(sp[(4 * d4 + e) * 65] * inv) & 0xffu) << (8 * e);
                w[d4] = pk; }
            *(GAS v4u*)(Q + (size_t)(n0 + n) * 2048 + k0 + 16 * c) = (v4u){w[0], w[1], w[2], w[3]};
        }
        LDS_WAIT(); asm volatile("" ::: "memory");
    }
}

constexpr int CONV_MOE_UNITS = (2 * 32 * 32 * 8 + 32 * 8 * 32) / 32;
__device__ __forceinline__ void conv_moe_unit(int c, int l, LAS unsigned char* lds, int wave, int lane_in) {
    int lane = lane_in; asm volatile("" : "+v"(lane));
    LAS float* scr = (LAS float*)(lds + wave * 16640);
    unsigned char* ws = karg_ws();
    const float* w_g = karg_in(I_WG) + (size_t)l * NEXP * 2048 * 512; const float* w_u = karg_in(I_WU) + (size_t)l * NEXP * 2048 * 512; const float* w_d = karg_in(I_WD) + (size_t)l * NEXP * 512 * 2048;
    unsigned char* WGU_T = ws + WS_WGU; unsigned char* WD_T = ws + WS_WD;
    constexpr int T_G = 32 * 32 * 8;
#define CM_DECODE(r_, W_, ldw_, k0_, n0_, D_, kd_, nd_, sc_) do { int r = (r_); \
        if (r < 2 * T_G) { const int which = r / T_G, r2 = r % T_G, e = r2 / 256, r3 = r2 % 256, kb = r3 / 8, nb = r3 % 8; \
            W_ = (which ? w_u : w_g) + (size_t)e * 2048 * 512; ldw_ = 512; k0_ = 64 * kb; n0_ = 64 * nb; D_ = WGU_T; kd_ = 2048; nd_ = e * 1024 + ((64 * nb) / 128) * 256 + which * 128 + ((64 * nb) % 128); sc_ = SC_WGU; } \
        else { r -= 2 * T_G; const int e = r / 256, r3 = r % 256, kb = r3 / 32, nb = r3 % 32; \
            W_ = w_d + (size_t)e * 512 * 2048; ldw_ = 2048; k0_ = 64 * kb; n0_ = 64 * nb; D_ = WD_T + (size_t)e * 2048 * 512; kd_ = 512; nd_ = 64 * nb; sc_ = SC_WD; } } while (0)
    const float* W0; int ldw0, k00, n00, kd0, nd0; unsigned char* D0; float sc0;
    CM_DECODE(32 * c + wave, W0, ldw0, k00, n00, D0, kd0, nd0, sc0);
    f32x4 va[16]; tr8_load(va, W0, ldw0, k00, n00, lane);
#pragma unroll 1
    for (int i = 0; i < 4; ++i) {
        const float* W1 = W0; int ldw1 = ldw0, k01 = k00, n01 = n00, kd1 = kd0, nd1 = nd0; unsigned char* D1 = D0; float sc1 = sc0;
        f32x4 vb[16];
        if (i + 1 < 4) { CM_DECODE(32 * c + 8 * (i + 1) + wave, W1, ldw1, k01, n01, D1, kd1, nd1, sc1); tr8_load(vb, W1, ldw1, k01, n01, lane); }
        tr8_finish(va, k00, D0, kd0, nd0, sc0, scr, lane);
        if (i + 1 < 4) {
#pragma unroll
            for (int q = 0; q < 16; ++q) va[q] = vb[q];
            W0 = W1; ldw0 = ldw1; k00 = k01; n00 = n01; kd0 = kd1; nd0 = nd1; D0 = D1; sc0 = sc1; }
    }
#undef CM_DECODE
    __syncthreads();
}

__device__ __forceinline__ void build_tp(const unsigned* cnt, volatile LAS int* tp, int tid) {
    if (tid < 64) {
        const int ln = hw_lane();
        const unsigned c = (ln < NEXP) ? __hip_atomic_load(cnt + ln, RLX_AGENT) : 0u;
        const int tiles = (int)((c + 255u) >> 8); int incl = tiles;
#pragma unroll
        for (int o = 1; o < 32; o <<= 1) { const int up = __builtin_amdgcn_ds_bpermute((ln - o) << 2, incl); if (ln >= o) incl += up; }
        if (ln < NEXP) tp[ln] = incl - tiles;
        if (ln == NEXP - 1) tp[NEXP] = incl;
    }
    __syncthreads();
}
template <int NT, bool COMBINE, int KB, bool A8 = false, bool XB16 = false, bool AB = false, bool Q8 = false>
__device__ __forceinline__ void norm_rows(int R0, const void* xin_, void* xout_, const unsigned char* Y, const v4u* route_prev, const LAS int* tp, bf16* Aout, const v4u* RW,
                                          LAS unsigned char* lds, f32x4 (&acc)[NT], float& rstd, int tid, bool noc, float* rowscale = nullptr) {
    constexpr int NB = 64 / KB, SL = KB * 2 * NT * 64, PPT = (SL + 511) / 512;
    const int lane = tid & 63, row = lane & 15, quad = lane >> 4; const size_t t = (size_t)R0 + row;
    const LAS float* gl = (const LAS float*)lds + quad * 8; LAS v4u* rwb = (LAS v4u*)(lds + 8192);
    const float* xp = (const float*)xin_ + t * 2048 + quad * 8; float* xo = (float*)xout_ + t * 2048 + quad * 8;
    const bf16* xp16 = (const bf16*)xin_ + t * 2048 + quad * 8; bf16* xo16 = (bf16*)xout_ + t * 2048 + quad * 8;
    float w0 = 0.f, w1 = 0.f; const unsigned char* y0 = Y; const unsigned char* y1 = Y;
    if constexpr (COMBINE) { const v4u r = route_prev[t]; const int s0 = tp[r.x >> 16] * 256 + (int)(r.x & 0xffffu), s1 = tp[r.y >> 16] * 256 + (int)(r.y & 0xffffu);
        w0 = __uint_as_float(r.z); w1 = __uint_as_float(r.w);
        if (noc) { w0 = 0.f; w1 = 0.f; }
        y0 = Y + (size_t)s0 * 2048 + quad * 8; y1 = Y + (size_t)s1 * 2048 + quad * 8; }
    bf16* ao = Aout + t * 2048 + quad * 8; unsigned char* ao8 = (unsigned char*)Aout + t * 2048 + quad * 8; unsigned char* ab8 = karg_ws() + WS_A8 + t * 2048 + quad * 8;
#define RW_GIDX(b_, j_, tb_) ((((tb_) + 512 * (j_)) / (KB * 64) * 64 + (b_) * KB) * 64 + ((tb_) + 512 * (j_)) % (KB * 64))
    float zz = 0.f; asm volatile("" : "+v"(zz));
#pragma unroll
    for (int n = 0; n < NT; ++n) acc[n] = (f32x4){zz, zz, zz, zz};
    float ss = 0.f, amax = 0.f;
    f32x4 xa[KB], xb[KB]; v4u xr[XB16 ? KB : 1]; v2u ya[COMBINE ? KB : 1], yb[COMBINE ? KB : 1]; v4u rwn[PPT];
    { int tb = tid; asm volatile("" : "+v"(tb));
#pragma unroll
    for (int j = 0; j < PPT; ++j) if (tb + 512 * j < SL) rwn[j] = RW[RW_GIDX(0, j, tb)]; }
#pragma unroll
    for (int k = 0; k < KB; ++k) { if constexpr (XB16) xr[k] = *(const GAS v4u*)(xp16 + k * 32); else { xa[k] = *(const GAS f32x4*)(xp + k * 32); xb[k] = *(const GAS f32x4*)(xp + k * 32 + 4); }
        if constexpr (COMBINE) { ya[k] = *(const GAS v2u*)(y0 + k * 32); yb[k] = *(const GAS v2u*)(y1 + k * 32); } }
#pragma unroll
    for (int j = 0; j < PPT; ++j) if (tid + 512 * j < SL) rwb[tid + 512 * j] = rwn[j];
    __syncthreads();
#pragma unroll 1
    for (int b = 0; b < NB; ++b) {
        f32x4 nxa[KB], nxb[KB]; v4u nxr[XB16 ? KB : 1]; v2u nya[COMBINE ? KB : 1], nyb[COMBINE ? KB : 1];
        const bool more = b + 1 < NB; const int kb1 = (b + 1) * KB;
        if (more) {
            int tb = tid; asm volatile("" : "+v"(tb));
#pragma unroll
            for (int j = 0; j < PPT; ++j) if (tb + 512 * j < SL) rwn[j] = RW[RW_GIDX(b + 1, j, tb)];
#pragma unroll
            for (int k = 0; k < KB; ++k) { if constexpr (XB16) nxr[k] = *(const GAS v4u*)(xp16 + (kb1 + k) * 32); else { nxa[k] = *(const GAS f32x4*)(xp + (kb1 + k) * 32); nxb[k] = *(const GAS f32x4*)(xp + (kb1 + k) * 32 + 4); }
                if constexpr (COMBINE) { nya[k] = *(const GAS v2u*)(y0 + (kb1 + k) * 32); nyb[k] = *(const GAS v2u*)(y1 + (kb1 + k) * 32); } }
        }
        const LAS v4u* cur = rwb + (b & 1) * SL + lane;
#pragma unroll
        for (int k = 0; k < KB; ++k) {
            const int ks = b * KB + k; f32x4 va, vb;
            if constexpr (XB16) { const v4u r_ = xr[k]; va = (f32x4){lo_f(r_.x), hi_f(r_.x), lo_f(r_.y), hi_f(r_.y)}; vb = (f32x4){lo_f(r_.z), hi_f(r_.z), lo_f(r_.w), hi_f(r_.w)}; } else { va = xa[k]; vb = xb[k]; }
            if constexpr (COMBINE) {
                float p_[8], q_[8]; unpack_fp8x8(ya[k], p_); unpack_fp8x8(yb[k], q_);
                va.x += w0 * p_[0] + w1 * q_[0]; va.y += w0 * p_[1] + w1 * q_[1]; va.z += w0 * p_[2] + w1 * q_[2]; va.w += w0 * p_[3] + w1 * q_[3];
                vb.x += w0 * p_[4] + w1 * q_[4]; vb.y += w0 * p_[5] + w1 * q_[5]; vb.z += w0 * p_[6] + w1 * q_[6]; vb.w += w0 * p_[7] + w1 * q_[7];
                if constexpr (XB16) { v4u w_; w_.x = pk2(va.x, va.y); w_.y = pk2(va.z, va.w); w_.z = pk2(vb.x, vb.y); w_.w = pk2(vb.z, vb.w); *(GAS v4u*)(xo16 + ks * 32) = w_;
                    va = (f32x4){lo_f(w_.x), hi_f(w_.x), lo_f(w_.y), hi_f(w_.y)}; vb = (f32x4){lo_f(w_.z), hi_f(w_.z), lo_f(w_.w), hi_f(w_.w)}; }
                else { *(GAS f32x4*)(xo + ks * 32) = va; *(GAS f32x4*)(xo + ks * 32 + 4) = vb; }
            }
            ss += (va.x * va.x + va.y * va.y) + (va.z * va.z + va.w * va.w) + (vb.x * vb.x + vb.y * vb.y) + (vb.z * vb.z + vb.w * vb.w);
            const f32x4 ga = *(const LAS f32x4*)(gl + ks * 32), gb = *(const LAS f32x4*)(gl + ks * 32 + 4);
            va = va * ga; vb = vb * gb;
            if constexpr (Q8) amax = fmaxf(amax, fmaxf(fmaxf(fmaxf(fabsf(va.x), fabsf(va.y)), fmaxf(fabsf(va.z), fabsf(va.w))), fmaxf(fmaxf(fabsf(vb.x), fabsf(vb.y)), fmaxf(fabsf(vb.z), fabsf(vb.w)))));
            v4u hi; hi.x = pk2(va.x, va.y); hi.y = pk2(va.z, va.w); hi.z = pk2(vb.x, vb.y); hi.w = pk2(vb.z, vb.w);
            v4u lo; lo.x = pk2(va.x - lo_f(hi.x), va.y - hi_f(hi.x)); lo.y = pk2(va.z - lo_f(hi.y), va.w - hi_f(hi.y)); lo.z = pk2(vb.x - lo_f(hi.z), vb.y - hi_f(hi.z)); lo.w = pk2(vb.z - lo_f(hi.w), vb.w - hi_f(hi.w));
            if constexpr (A8) { v2u w8; w8.x = pk_fp8x4(va.x, va.y, va.z, va.w); w8.y = pk_fp8x4(vb.x, vb.y, vb.z, vb.w); *(GAS v2u*)(ao8 + ks * 32) = w8; }
            else if constexpr (!Q8) *(GAS v4u*)(ao + ks * 32) = hi;
            if constexpr (AB) { v2u w8; w8.x = pk_fp8x4(va.x, va.y, va.z, va.w); w8.y = pk_fp8x4(vb.x, vb.y, vb.z, vb.w); *(GAS v2u*)(ab8 + ks * 32) = w8; }
            const bf16x8 ah = __builtin_bit_cast(bf16x8, hi), al = __builtin_bit_cast(bf16x8, lo);
#pragma unroll
            for (int n = 0; n < NT; ++n) {
                const bf16x8 bh = __builtin_bit_cast(bf16x8, cur[((0 * NT + n) * KB + k) * 64]), bl = __builtin_bit_cast(bf16x8, cur[((1 * NT + n) * KB + k) * 64]);
                acc[n] = MFMA16(ah, bh, acc[n]); acc[n] = MFMA16(al, bh, acc[n]); acc[n] = MFMA16(ah, bl, acc[n]);
            }
            __builtin_amdgcn_sched_barrier(0);
        }
        if (more) {
#pragma unroll
            for (int j = 0; j < PPT; ++j) if (tid + 512 * j < SL) rwb[((b + 1) & 1) * SL + tid + 512 * j] = rwn[j];
#pragma unroll
            for (int k = 0; k < KB; ++k) { if constexpr (XB16) xr[k] = nxr[k]; else { xa[k] = nxa[k]; xb[k] = nxb[k]; } if constexpr (COMBINE) { ya[k] = nya[k]; yb[k] = nyb[k]; } }
        }
        __syncthreads();
    }
    ss += sx(ss, 16); ss += sx(ss, 32);
    rstd = 1.0f / sqrtf(ss * (1.0f / 2048.0f) + EPS);
    if constexpr (Q8) {
        amax = fmaxf(amax, sx(amax, 16)); amax = fmaxf(amax, sx(amax, 32));
        const float qs = amax > 0.f ? 127.0f / amax : 0.f;
        asm volatile("s_waitcnt vmcnt(0)" ::: "memory");
        signed char* aq = (signed char*)Aout + t * 2048 + quad * 8;
#pragma unroll 1
        for (int b = 0; b < 16; ++b) {
            f32x4 qa[4], qb[4]; v4u qr[XB16 ? 4 : 1];
#pragma unroll
            for (int k = 0; k < 4; ++k) { const int ks = b * 4 + k; if constexpr (XB16) qr[k] = *(const GAS v4u*)((COMBINE ? (const bf16*)xo16 : xp16) + ks * 32); else { qa[k] = *(const GAS f32x4*)(xp + ks * 32); qb[k] = *(const GAS f32x4*)(xp + ks * 32 + 4); } }
#pragma unroll
            for (int k = 0; k < 4; ++k) { const int ks = b * 4 + k; f32x4 va, vb;
                if constexpr (XB16) { const v4u r_ = qr[k]; va = (f32x4){lo_f(r_.x), hi_f(r_.x), lo_f(r_.y), hi_f(r_.y)}; vb = (f32x4){lo_f(r_.z), hi_f(r_.z), lo_f(r_.w), hi_f(r_.w)}; } else { va = qa[k]; vb = qb[k]; }
                const f32x4 ga = *(const LAS f32x4*)(gl + ks * 32), gb = *(const LAS f32x4*)(gl + ks * 32 + 4);
                va = va * ga * qs; vb = vb * gb * qs;
                v2u w; w.x = ((unsigned)(int)__builtin_rintf(va.x) & 0xffu) | (((unsigned)(int)__builtin_rintf(va.y) & 0xffu) << 8) | (((unsigned)(int)__builtin_rintf(va.z) & 0xffu) << 16) | ((unsigned)(int)__builtin_rintf(va.w) << 24);
                w.y = ((unsigned)(int)__builtin_rintf(vb.x) & 0xffu) | (((unsigned)(int)__builtin_rintf(vb.y) & 0xffu) << 8) | (((unsigned)(int)__builtin_rintf(vb.z) & 0xffu) << 16) | ((unsigned)(int)__builtin_rintf(vb.w) << 24);
                *(GAS v2u*)(aq + ks * 32) = w; }
        }
        *rowscale = rstd * amax * (1.0f / 127.0f);
    }
#undef RW_GIDX
}
__device__ __forceinline__ void stage_gain(const float* g, LAS unsigned char* lds, int tid) { *(LAS f32x4*)(lds + tid * 16) = *(const GAS f32x4*)(g + tid * 4); __syncthreads(); }
template <bool COMBINE>
__device__ __forceinline__ void norm1_phase(const Args& a, int l, const LAS int* tp, LAS unsigned char* lds, int vcu, int G, int wave, int tid) {
    unsigned char* ws = karg_ws(); const int lane = tid & 63;
    const void* xin = COMBINE ? (const void*)(ws + WS_XB) : (const void*)karg_in(I_X);
    bf16* A = (bf16*)(ws + (G1_I8 ? WS_A8 : WS_BUFA)); float* RSTD = (float*)(ws + WS_RSTD); float* GATES = (float*)(ws + WS_GATES);
    stage_gain(karg_in(I_N1G) + l * 2048, lds, tid);
    for (int grp0 = vcu * 8; grp0 < MTOK / 16; grp0 += G * 8) {
        const int grp = grp0 + wave; f32x4 acc[1]; float rstd, rsc;
        norm_rows<1, COMBINE, COMBINE ? 2 : (G1_I8 ? 4 : 8), false, COMBINE, G1_SPLIT != 0, G1_I8 != 0>(grp * 16, xin, ws + WS_XB, (const unsigned char*)(ws + WS_Y), (const v4u*)(ws + WS_ROUTE), tp, A, (const v4u*)(ws + WS_RWG + l * RW_LSTRIDE), lds, acc, rstd, tid, (karg_flags() & 8) != 0, &rsc);
        if (!G1_I8) rsc = rstd;
        const int quad = lane >> 4;
        if (quad == 0) RSTD[grp * 16 + lane] = rsc;
#pragma unroll
        for (int j = 0; j < 4; ++j) { const float rs = sidx(rstd, quad * 4 + j); GATES[(size_t)(grp * 16 + quad * 4 + j) * 16 + (lane & 15)] = acc[0][j] * rs; }
    }
}
template <bool COMBINE>
__device__ __forceinline__ void norm1_i8_phase(int l, const LAS int* tp, LAS unsigned char* lds, int vcu, int G, int wave, int tid) {
    unsigned char* ws = karg_ws(); const int lane = tid & 63, row = lane & 15, quad = lane >> 4;
    const float* xin = karg_in(I_X); bf16* XB = (bf16*)(ws + WS_XB); const unsigned char* Y = ws + WS_Y; const v4u* route_prev = (const v4u*)(ws + WS_ROUTE);
    signed char* A8 = (signed char*)(ws + WS_A8); float* RSTD = (float*)(ws + WS_RSTD); float* GATES = (float*)(ws + WS_GATES);
    const bool noc = (karg_flags() & 8) != 0;
    LAS v4u* rwl = (LAS v4u*)(lds + 8192); LAS float* part = (LAS float*)(lds + 8192 + 131072); LAS float* dpart = part + 256;
    { const v4u* RW = (const v4u*)(ws + WS_RWG + l * RW_LSTRIDE);
#pragma unroll
      for (int j = 0; j < 16; ++j) rwl[tid + 512 * j] = RW[tid + 512 * j]; }
    stage_gain(karg_in(I_N1G) + l * 2048, lds, tid);
    const LAS float* gl = (const LAS float*)lds + 256 * wave + 8 * quad;
    const int c0 = 256 * wave + 8 * quad;
    v4u rnext = {0u, 0u, 0u, 0u};
    if constexpr (COMBINE) { if (vcu < MTOK / 16) rnext = route_prev[(size_t)vcu * 16 + row]; }
#pragma unroll 1
    for (int grp = vcu; grp < MTOK / 16; grp += G) {
        const size_t t = (size_t)grp * 16 + row;
        float xg[8][8]; float ss = 0.f, amax = 0.f; f32x4 acc = {0.f, 0.f, 0.f, 0.f};
        if constexpr (!COMBINE) {
            f32x4 xa[8], xb[8];
#pragma unroll
            for (int ks = 0; ks < 8; ++ks) { xa[ks] = *(const GAS f32x4*)(xin + t * 2048 + c0 + 32 * ks); xb[ks] = *(const GAS f32x4*)(xin + t * 2048 + c0 + 32 * ks + 4); }
#pragma unroll
            for (int ks = 0; ks < 8; ++ks) { xg[ks][0] = xa[ks].x; xg[ks][1] = xa[ks].y; xg[ks][2] = xa[ks].z; xg[ks][3] = xa[ks].w; xg[ks][4] = xb[ks].x; xg[ks][5] = xb[ks].y; xg[ks][6] = xb[ks].z; xg[ks][7] = xb[ks].w; }
        } else {
            const v4u r = rnext; if (grp + G < MTOK / 16) rnext = route_prev[(size_t)(grp + G) * 16 + row];
            const int s0 = tp[r.x >> 16] * 256 + (int)(r.x & 0xffffu), s1 = tp[r.y >> 16] * 256 + (int)(r.y & 0xffffu);
            float w0 = __uint_as_float(r.z), w1 = __uint_as_float(r.w); if (noc) { w0 = 0.f; w1 = 0.f; }
            v4u xr[8]; v2u ya[8], yb[8];
#pragma unroll
            for (int ks = 0; ks < 8; ++ks) { xr[ks] = *(const GAS v4u*)(XB + t * 2048 + c0 + 32 * ks); ya[ks] = *(const GAS v2u*)(Y + (size_t)s0 * 2048 + c0 + 32 * ks); yb[ks] = *(const GAS v2u*)(Y + (size_t)s1 * 2048 + c0 + 32 * ks); }
#pragma unroll
            for (int ks = 0; ks < 8; ++ks) { float p_[8], q_[8], x_[8]; unpack8(xr[ks], x_); unpack_fp8x8(ya[ks], p_); unpack_fp8x8(yb[ks], q_);
#pragma unroll
                for (int e = 0; e < 8; ++e) x_[e] += w0 * p_[e] + w1 * q_[e];
                const v4u wb = pack8(x_); *(GAS v4u*)(XB + t * 2048 + c0 + 32 * ks) = wb;
                unpack8(wb, x_);
#pragma unroll
                for (int e = 0; e < 8; ++e) xg[ks][e] = x_[e]; }
        }
#pragma unroll
        for (int ks = 0; ks < 8; ++ks) {
            const f32x4 ga = *(const LAS f32x4*)(gl + 32 * ks), gb = *(const LAS f32x4*)(gl + 32 * ks + 4); const float g8[8] = {ga.x, ga.y, ga.z, ga.w, gb.x, gb.y, gb.z, gb.w};
#pragma unroll
            for (int e = 0; e < 8; ++e) { ss += xg[ks][e] * xg[ks][e]; xg[ks][e] *= g8[e]; amax = fmaxf(amax, fabsf(xg[ks][e])); }
            v4u hi; hi.x = pk2(xg[ks][0], xg[ks][1]); hi.y = pk2(xg[ks][2], xg[ks][3]); hi.z = pk2(xg[ks][4], xg[ks][5]); hi.w = pk2(xg[ks][6], xg[ks][7]);
            v4u lo; lo.x = pk2(xg[ks][0] - lo_f(hi.x), xg[ks][1] - hi_f(hi.x)); lo.y = pk2(xg[ks][2] - lo_f(hi.y), xg[ks][3] - hi_f(hi.y)); lo.z = pk2(xg[ks][4] - lo_f(hi.z), xg[ks][5] - hi_f(hi.z)); lo.w = pk2(xg[ks][6] - lo_f(hi.w), xg[ks][7] - hi_f(hi.w));
            const int ksg = 8 * wave + ks;
            const bf16x8 bh = __builtin_bit_cast(bf16x8, rwl[ksg * 64 + lane]), bl = __builtin_bit_cast(bf16x8, rwl[(64 + ksg) * 64 + lane]);
            const bf16x8 ah = __builtin_bit_cast(bf16x8, hi), al = __builtin_bit_cast(bf16x8, lo);
            acc = MFMA16(ah, bh, acc); acc = MFMA16(al, bh, acc); acc = MFMA16(ah, bl, acc);
        }
        ss += sx(ss, 16); ss += sx(ss, 32); amax = fmaxf(amax, sx(amax, 16)); amax = fmaxf(amax, sx(amax, 32));
        if (quad == 0) { part[(wave * 16 + row) * 2] = ss; part[(wave * 16 + row) * 2 + 1] = amax; }
        *(LAS f32x4*)(dpart + wave * 256 + lane * 4) = acc;
        __syncthreads();
        float sst = 0.f, amt = 0.f;
#pragma unroll
        for (int w8 = 0; w8 < 8; ++w8) { sst += part[(w8 * 16 + row) * 2]; amt = fmaxf(amt, part[(w8 * 16 + row) * 2 + 1]); }
        const float rstd = 1.0f / sqrtf(sst * (1.0f / 2048.0f) + EPS), qs = amt > 0.f ? 127.0f / amt : 0.f;
        if (wave == 0) {
            f32x4 d = {0.f, 0.f, 0.f, 0.f};
#pragma unroll
            for (int w8 = 0; w8 < 8; ++w8) d = d + *(const LAS f32x4*)(dpart + w8 * 256 + lane * 4);
            if (quad == 0) RSTD[t] = rstd * amt * (1.0f / 127.0f);
#pragma unroll
            for (int j = 0; j < 4; ++j) { const float rs = sidx(rstd, quad * 4 + j); GATES[(size_t)(grp * 16 + quad * 4 + j) * 16 + (lane & 15)] = d[j] * rs; }
        }
#pragma unroll
        for (int ks = 0; ks < 8; ++ks) { v2u w;
            w.x = ((unsigned)(int)__builtin_rintf(xg[ks][0] * qs) & 0xffu) | (((unsigned)(int)__builtin_rintf(xg[ks][1] * qs) & 0xffu) << 8) | (((unsigned)(int)__builtin_rintf(xg[ks][2] * qs) & 0xffu) << 16) | ((unsigned)(int)__builtin_rintf(xg[ks][3] * qs) << 24);
            w.y = ((unsigned)(int)__builtin_rintf(xg[ks][4] * qs) & 0xffu) | (((unsigned)(int)__builtin_rintf(xg[ks][5] * qs) & 0xffu) << 8) | (((unsigned)(int)__builtin_rintf(xg[ks][6] * qs) & 0xffu) << 16) | ((unsigned)(int)__builtin_rintf(xg[ks][7] * qs) << 24);
            *(GAS v2u*)(A8 + t * 2048 + c0 + 32 * ks) = w; }
        __syncthreads();
    }
}
__device__ __forceinline__ void norm2_phase(const Args& a, int l, LAS unsigned char* lds, int vcu, int G, int wave, int tid) {
    unsigned char* ws = karg_ws(); const int lane = tid & 63;
    const float* b_rg = karg_in(I_BRG) + l * 4; const float* b_re = karg_in(I_BRE) + l * 32;
    bf16* A = (bf16*)(ws + WS_A8); float* RSTD = (float*)(ws + WS_RSTD);
    unsigned* cnt = (unsigned*)(ws + WS_CTL) + CW_CNT + 64 * l; int* list = (int*)(ws + WS_LIST); v4u* route = (v4u*)(ws + WS_ROUTE);
    LAS unsigned* lcnt = (LAS unsigned*)(lds + 8192 + 98304 + 8 * 3072); LAS unsigned* lbase = lcnt + 32;
    if (tid < 32) lcnt[tid] = 0u;
    stage_gain(karg_in(I_N2G) + l * 2048, lds, tid);
    for (int grp0 = vcu * 8; grp0 < MTOK / 16; grp0 += G * 8) {
        const int grp = grp0 + wave; f32x4 acc[3]; float rstd;
        norm_rows<3, false, 8, true, true>(grp * 16, ws + WS_XB, nullptr, nullptr, nullptr, nullptr, A, (const v4u*)(ws + WS_RWR + l * RW_LSTRIDE), lds, acc, rstd, tid, false);
        LAS float* scr = (LAS float*)(lds + 8192 + 98304 + wave * 3072);
        const int ln2 = hw_lane();
        const int quad = ln2 >> 4;
        if (quad == 0) RSTD[grp * 16 + ln2] = rstd;
#pragma unroll
        for (int n = 0; n < 3; ++n)
#pragma unroll
            for (int j = 0; j < 4; ++j) scr[(quad * 4 + j) * 48 + n * 16 + (ln2 & 15)] = acc[n][j];
        LDS_WAIT(); asm volatile("" ::: "memory");
        int e1 = 0, e2 = 0; unsigned l1 = 0u, l2 = 0u; float w1v = 0.f, w2v = 0.f;
        if (ln2 < 16) {
            const LAS float* L = scr + ln2 * 48;
            float lg[4];
#pragma unroll
            for (int c = 0; c < 4; ++c) lg[c] = L[c] * rstd + b_rg[c];
            int gi = 0; float gm = lg[0];
#pragma unroll
            for (int c = 1; c < 4; ++c) if (lg[c] > gm) { gm = lg[c]; gi = c; }
            float gs = 0.f;
#pragma unroll
            for (int c = 0; c < 4; ++c) gs += __expf(lg[c] - gm);
            const float pg = 1.0f / gs;
            float le[8];
#pragma unroll
            for (int j = 0; j < 8; ++j) le[j] = L[4 + gi * 8 + j] * rstd + b_re[gi * 8 + j];
            int i1 = 0; float v1 = le[0];
#pragma unroll
            for (int j = 1; j < 8; ++j) if (le[j] > v1) { v1 = le[j]; i1 = j; }
            int i2 = -1; float v2 = -INFINITY;
#pragma unroll
            for (int j = 0; j < 8; ++j) if (j != i1 && le[j] > v2) { v2 = le[j]; i2 = j; }
            const float d = __expf(v2 - v1), wa = pg / (1.0f + d), wb = pg * d / (1.0f + d);
            e1 = gi * 8 + i1; e2 = gi * 8 + i2; w1v = wa; w2v = wb;
            l1 = __hip_atomic_fetch_add(lcnt + e1, 1u, __ATOMIC_RELAXED, __HIP_MEMORY_SCOPE_WORKGROUP); l2 = __hip_atomic_fetch_add(lcnt + e2, 1u, __ATOMIC_RELAXED, __HIP_MEMORY_SCOPE_WORKGROUP);
        }
        __syncthreads();
        { const int tt = wave * 64 + ln2;
            if (tt < NEXP) { const unsigned n = lcnt[tt]; lbase[tt] = n ? __hip_atomic_fetch_add(cnt + tt, n, RLX_AGENT) : 0u; lcnt[tt] = 0u; } }
        __syncthreads();
        if (ln2 < 16) {
            const int t = grp * 16 + ln2; const unsigned r1 = lbase[e1] + l1, r2 = lbase[e2] + l2;
            list[e1 * 32768 + (int)r1] = t; list[e2 * 32768 + (int)r2] = t;
            v4u ro; ro.x = ((unsigned)e1 << 16) | r1; ro.y = ((unsigned)e2 << 16) | r2; ro.z = __builtin_bit_cast(unsigned, w1v); ro.w = __builtin_bit_cast(unsigned, w2v);
            route[t] = ro;
        }
        __syncthreads();
    }
}
__device__ __forceinline__ void norm2_sp_phase(int l, LAS unsigned char* lds, int vcu, int G, int wave, int tid) {
    unsigned char* ws = karg_ws(); const int lane = tid & 63, row = lane & 15, quad = lane >> 4;
    const float* b_rg = karg_in(I_BRG) + l * 4; const float* b_re = karg_in(I_BRE) + l * 32;
    const bf16* XB = (const bf16*)(ws + WS_XB); unsigned char* A8 = ws + WS_A8; float* RSTD = (float*)(ws + WS_RSTD);
    unsigned* cnt = (unsigned*)(ws + WS_CTL) + CW_CNT + 64 * l; int* list = (int*)(ws + WS_LIST); v4u* route = (v4u*)(ws + WS_ROUTE);
    LAS float* part = (LAS float*)(lds + 8192); LAS float* dpart = (LAS float*)(lds + 9216); LAS float* scr = (LAS float*)(lds + 58368) + wave * 768;
    LAS v4u* rec = (LAS v4u*)(lds + 82944); LAS unsigned* lcnt = (LAS unsigned*)(lds + 82944 + 8192); LAS unsigned* lbase = lcnt + 32;
    if (tid < 32) lcnt[tid] = 0u;
    v4u wf[3][8];
    { const v4u* RW = (const v4u*)(ws + WS_RWR + l * RW_LSTRIDE);
#pragma unroll
      for (int n = 0; n < 3; ++n)
#pragma unroll
          for (int ks = 0; ks < 8; ++ks) wf[n][ks] = RW[(n * 64 + 8 * wave + ks) * 64 + lane]; }
    stage_gain(karg_in(I_N2G) + l * 2048, lds, tid);
    const LAS float* gl = (const LAS float*)lds + 256 * wave + 8 * quad;
    const int c0 = 256 * wave + 8 * quad;
    v4u xr[8];
    if (vcu < MTOK / 16) {
#pragma unroll
        for (int ks = 0; ks < 8; ++ks) xr[ks] = *(const GAS v4u*)(XB + ((size_t)vcu * 16 + row) * 2048 + c0 + 32 * ks); }
    int k = 0;
#pragma unroll 1
    for (int grp = vcu; grp < MTOK / 16; grp += G, ++k) {
        const size_t t = (size_t)grp * 16 + row; const int buf = k & 1;
        const bool more = grp + G < MTOK / 16;
        float zz = 0.f; asm volatile("" : "+v"(zz));
        f32x4 acc[3] = {{zz, zz, zz, zz}, {zz, zz, zz, zz}, {zz, zz, zz, zz}}; float ss = 0.f;
#pragma unroll
        for (int ks = 0; ks < 8; ++ks) {
            float x_[8]; unpack8(xr[ks], x_);
            const f32x4 ga = *(const LAS f32x4*)(gl + 32 * ks), gb = *(const LAS f32x4*)(gl + 32 * ks + 4); const float g8[8] = {ga.x, ga.y, ga.z, ga.w, gb.x, gb.y, gb.z, gb.w};
#pragma unroll
            for (int e = 0; e < 8; ++e) { ss += x_[e] * x_[e]; x_[e] *= g8[e]; }
            { v2u w8; w8.x = pk_fp8x4(x_[0], x_[1], x_[2], x_[3]); w8.y = pk_fp8x4(x_[4], x_[5], x_[6], x_[7]); *(GAS v2u*)(A8 + t * 2048 + c0 + 32 * ks) = w8; }
            v4u hi; hi.x = pk2(x_[0], x_[1]); hi.y = pk2(x_[2], x_[3]); hi.z = pk2(x_[4], x_[5]); hi.w = pk2(x_[6], x_[7]);
            v4u lo; lo.x = pk2(x_[0] - lo_f(hi.x), x_[1] - hi_f(hi.x)); lo.y = pk2(x_[2] - lo_f(hi.y), x_[3] - hi_f(hi.y)); lo.z = pk2(x_[4] - lo_f(hi.z), x_[5] - hi_f(hi.z)); lo.w = pk2(x_[6] - lo_f(hi.w), x_[7] - hi_f(hi.w));
            const bf16x8 ah = __builtin_bit_cast(bf16x8, hi), al = __builtin_bit_cast(bf16x8, lo);
#pragma unroll
            for (int n = 0; n < 3; ++n) { const bf16x8 bh = __builtin_bit_cast(bf16x8, wf[n][ks]); acc[n] = MFMA16(ah, bh, acc[n]); acc[n] = MFMA16(al, bh, acc[n]); }
            if (ks & 1) __builtin_amdgcn_sched_barrier(0);
        }
        if (more) {
#pragma unroll
            for (int ks = 0; ks < 8; ++ks) xr[ks] = *(const GAS v4u*)(XB + ((size_t)(grp + G) * 16 + row) * 2048 + c0 + 32 * ks); }
        { auto r16 = __builtin_amdgcn_permlane16_swap(__float_as_uint(ss), __float_as_uint(ss), false, false); ss = __uint_as_float(r16[0]) + __uint_as_float(r16[1]);
          auto r32 = __builtin_amdgcn_permlane32_swap(__float_as_uint(ss), __float_as_uint(ss), false, false); ss = __uint_as_float(r32[0]) + __uint_as_float(r32[1]); }
        if (quad == 0) part[(buf * 8 + wave) * 16 + row] = ss;
#pragma unroll
        for (int n = 0; n < 3; ++n) *(LAS f32x4*)(dpart + ((buf * 8 + wave) * 3 + n) * 256 + lane * 4) = acc[n];
        __syncthreads();
        if (wave == (k & 7)) {
            f32x4 d[3] = {{zz, zz, zz, zz}, {zz, zz, zz, zz}, {zz, zz, zz, zz}}; float sst = 0.f;
#pragma unroll 2
            for (int w8 = 0; w8 < 8; ++w8) { sst += part[(buf * 8 + w8) * 16 + row];
#pragma unroll
                for (int n = 0; n < 3; ++n) d[n] = d[n] + *(const LAS f32x4*)(dpart + ((buf * 8 + w8) * 3 + n) * 256 + lane * 4); }
            const float rstd = 1.0f / sqrtf(sst * (1.0f / 2048.0f) + EPS);
            if (quad == 0) RSTD[t] = rstd;
#pragma unroll
            for (int n = 0; n < 3; ++n)
#pragma unroll
                for (int j = 0; j < 4; ++j) scr[(quad * 4 + j) * 48 + n * 16 + row] = d[n][j];
            LDS_WAIT(); asm volatile("" ::: "memory");
            if (lane < 16) {
                const LAS float* L = scr + lane * 48;
                float lg[4];
#pragma unroll
                for (int c = 0; c < 4; ++c) lg[c] = L[c] * rstd + b_rg[c];
                int gi = 0; float gm = lg[0];
#pragma unroll
                for (int c = 1; c < 4; ++c) if (lg[c] > gm) { gm = lg[c]; gi = c; }
                float gs = 0.f;
#pragma unroll
                for (int c = 0; c < 4; ++c) gs += __expf(lg[c] - gm);
                const float pg = 1.0f / gs;
                float le[8];
#pragma unroll
                for (int j = 0; j < 8; ++j) le[j] = L[4 + gi * 8 + j] * rstd + b_re[gi * 8 + j];
                int i1 = 0; float v1 = le[0];
#pragma unroll
                for (int j = 1; j < 8; ++j) if (le[j] > v1) { v1 = le[j]; i1 = j; }
                int i2 = -1; float v2 = -INFINITY;
#pragma unroll
                for (int j = 0; j < 8; ++j) if (j != i1 && le[j] > v2) { v2 = le[j]; i2 = j; }
                const float dd = __expf(v2 - v1), wa = pg / (1.0f + dd), wb = pg * dd / (1.0f + dd);
                const int e1 = gi * 8 + i1, e2 = gi * 8 + i2;
                const unsigned l1 = __hip_atomic_fetch_add(lcnt + e1, 1u, __ATOMIC_RELAXED, __HIP_MEMORY_SCOPE_WORKGROUP), l2 = __hip_atomic_fetch_add(lcnt + e2, 1u, __ATOMIC_RELAXED, __HIP_MEMORY_SCOPE_WORKGROUP);
                v4u ro; ro.x = ((unsigned)e1 << 16) | l1; ro.y = ((unsigned)e2 << 16) | l2; ro.z = __float_as_uint(wa); ro.w = __float_as_uint(wb);
                rec[k * 16 + lane] = ro;
            }
        }
    }
    __syncthreads();
    if (tid < NEXP) { const unsigned n = lcnt[tid]; lbase[tid] = n ? __hip_atomic_fetch_add(cnt + tid, n, RLX_AGENT) : 0u; }
    __syncthreads();
    for (int ri = tid; ri < 16 * k; ri += 512) {
        const v4u ro = rec[ri]; const int grp = vcu + (ri >> 4) * G, t = grp * 16 + (ri & 15);
        const unsigned e1 = ro.x >> 16, e2 = ro.y >> 16, r1 = lbase[e1] + (ro.x & 0xffffu), r2 = lbase[e2] + (ro.y & 0xffffu);
        list[e1 * 32768 + r1] = t; list[e2 * 32768 + r2] = t;
        v4u o; o.x = (e1 << 16) | r1; o.y = (e2 << 16) | r2; o.z = ro.z; o.w = ro.w;
        route[t] = o;
    }
    __syncthreads();
}
__device__ __forceinline__ void final_phase(const Args& a, const LAS int* tp, int gw, int NGW, int lane) {
    unsigned char* ws = karg_ws(); const unsigned char* Y = ws + WS_Y; const v4u* route = (const v4u*)(ws + WS_ROUTE);
    v4u rnext = {0u, 0u, 0u, 0u}; if (gw < MTOK) rnext = route[gw];
    for (int t = gw; t < MTOK; t += NGW) {
        const v4u r = rnext; if (t + NGW < MTOK) rnext = route[t + NGW];
        const int s0 = tp[r.x >> 16] * 256 + (int)(r.x & 0xffffu), s1 = tp[r.y >> 16] * 256 + (int)(r.y & 0xffffu);
        float w0 = __uint_as_float(r.z), w1 = __uint_as_float(r.w);
        if (karg_flags() & 8) { w0 = 0.f; w1 = 0.f; }
        float* xo = karg_out() + (size_t)t * 2048 + lane * 8; const bf16* xi = (const bf16*)(ws + WS_XB) + (size_t)t * 2048 + lane * 8;
        const unsigned char* y0 = Y + (size_t)s0 * 2048 + lane * 8; const unsigned char* y1 = Y + (size_t)s1 * 2048 + lane * 8;
#pragma unroll
        for (int j = 0; j < 4; ++j) {
            const v4u xr = *(const GAS v4u*)(xi + j * 512);
            f32x4 xa = {lo_f(xr.x), hi_f(xr.x), lo_f(xr.y), hi_f(xr.y)}, xb = {lo_f(xr.z), hi_f(xr.z), lo_f(xr.w), hi_f(xr.w)};
            float p_[8], q_[8]; unpack_fp8x8(*(const GAS v2u*)(y0 + j * 512), p_); unpack_fp8x8(*(const GAS v2u*)(y1 + j * 512), q_);
            xa.x += w0 * p_[0] + w1 * q_[0]; xa.y += w0 * p_[1] + w1 * q_[1]; xa.z += w0 * p_[2] + w1 * q_[2]; xa.w += w0 * p_[3] + w1 * q_[3];
            xb.x += w0 * p_[4] + w1 * q_[4]; xb.y += w0 * p_[5] + w1 * q_[5]; xb.z += w0 * p_[6] + w1 * q_[6]; xb.w += w0 * p_[7] + w1 * q_[7];
#ifdef PROBE_EXPR
            { const float pv = (PROBE_EXPR); xa = xa + pv; xb = xb + pv; }
#endif
            *(GAS f32x4*)(xo + j * 512) = xa; *(GAS f32x4*)(xo + j * 512 + 4) = xb;
        }
    }
}

__device__ __forceinline__ void qkn_phase(const Args& a, int l, int gw, int NGW, int lane) {
    bf16* PROJ = (bf16*)(karg_ws() + WS_PROJ); const f32x4* rope = (const f32x4*)(karg_ws() + WS_ROPE);
    const float* qg = karg_in(I_QNG) + l * 64; const float* kg = karg_in(I_KNG) + l * 64;
    const int c8 = lane & 7;
    float gq[8], gk[8];
#pragma unroll
    for (int j = 0; j < 8; ++j) { gq[j] = qg[c8 * 8 + j] * QSCALE; gk[j] = kg[c8 * 8 + j]; }
    for (int grp = gw; grp < MTOK / 16; grp += NGW) {
#pragma unroll 1
        for (int it = 0; it < 4; ++it) {
            const int t0 = grp * 16 + it * 4;
            v4u raw[4][3];
#pragma unroll
            for (int k = 0; k < 4; ++k)
#pragma unroll
                for (int i = 0; i < 3; ++i) raw[k][i] = *(const GAS v4u*)(PROJ + (size_t)(t0 + k) * NPROJ + C_DAQ + (lane + 64 * i) * 8);
#pragma unroll
            for (int k = 0; k < 4; ++k) {
                const f32x4* rp = rope + (size_t)((t0 + k) & (SEQ - 1)) * 4;
                const f32x4 c0 = rp[0], c1 = rp[1], s0 = rp[2], s1 = rp[3];
                const float cs[8] = {c0.x, c0.y, c0.z, c0.w, c1.x, c1.y, c1.z, c1.w}, sn[8] = {s0.x, s0.y, s0.z, s0.w, s1.x, s1.y, s1.z, s1.w};
#pragma unroll
                for (int i = 0; i < 3; ++i) {
                    const bool isq = (lane + 64 * i) < 96;
                    float x[8]; unpack8(raw[k][i], x);
                    float ss = 0.f;
#pragma unroll
                    for (int j = 0; j < 8; ++j) ss += x[j] * x[j];
                    ss += sx(ss, 1); ss += sx(ss, 2); ss += sx(ss, 4);
                    const float rs = 1.0f / sqrtf(ss * (1.0f / 64.0f) + EPS);
#pragma unroll
                    for (int j = 0; j < 8; ++j) x[j] = x[j] * rs * (isq ? gq[j] : gk[j]);
                    float px[8];
#pragma unroll
                    for (int j = 0; j < 8; ++j) px[j] = sx(x[j], 1);
                    if (c8 == 0) {
#pragma unroll
                        for (int j = 0; j < 8; ++j) x[j] = x[j] * cs[j] - px[j] * sn[j];
                    } else if (c8 == 1) {
#pragma unroll
                        for (int j = 0; j < 8; ++j) x[j] = x[j] * cs[j] + px[j] * sn[j];
                    }
                    raw[k][i] = pack8(x);
                }
            }
#pragma unroll
            for (int k = 0; k < 4; ++k)
#pragma unroll
                for (int i = 0; i < 3; ++i) *(GAS v4u*)(PROJ + (size_t)(t0 + k) * NPROJ + C_DAQ + (lane + 64 * i) * 8) = raw[k][i];
        }
    }
}

struct MixP { const bf16* PROJ; bf16* MIX; const float* GATES; const float *vng, *gws, *gmb, *convw, *convb, *igb, *fgb, *mlng, *lamp, *subg; float lambda_init; };

__device__ __forceinline__ MixP make_mixp(const Args& args, int l_in) {
    int l = l_in; asm volatile("" : "+s"(l));
    unsigned char* ws = karg_ws(); MixP P;
    P.PROJ = (const bf16*)(ws + WS_PROJ); P.MIX = (bf16*)(ws + WS_BUFB); P.GATES = (const float*)(ws + WS_GATES);
    P.vng = karg_in(I_GMVG) + l * 512; P.gws = karg_in(I_GMWS) + l * 4 * 128 * 128; P.gmb = karg_in(I_GMB) + l * 512;
    P.convw = karg_in(I_CONVW) + l * 4 * 768; P.convb = karg_in(I_CONVB) + l * 768; P.igb = karg_in(I_IGB) + l * 6; P.fgb = karg_in(I_FGB) + l * 6; P.mlng = karg_in(I_MLNG) + l * 768;
    P.lamp = karg_in(I_LAM) + l * 256; P.subg = karg_in(I_SUBG) + l * 128; P.lambda_init = (l == 0) ? 0.2f : 0.35550906759096934f;
    return P;
}

__device__ __forceinline__ void gmlp_unit(int u, int l, const Args& args, LAS unsigned char* lds, int tid_in, int wave, int lane_in) {
    const MixP P = make_mixp(args, l);
    int tid = tid_in; asm volatile("" : "+v"(tid)); const int lane = tid & 63; (void)lane_in;
    const int g = u & 3, T0 = (u >> 2) * 128;
    LAS bf16* Vn = (LAS bf16*)lds;
    const int ti = wave >> 1, dj0 = (wave & 1) * 2, r = lane & 31, h = lane >> 5, q = (lane & 15) >> 2, p = lane & 3, nh = (lane >> 4) & 1;
    const int trow = 32 * ti + r;
    v4u vraw[4], uraw[4]; float bsv[4];
#pragma unroll
    for (int k = 0; k < 4; ++k) { const int id = tid + 512 * k, row = id >> 4, c16 = id & 15;
        vraw[k] = *(const GAS v4u*)(P.PROJ + (size_t)(T0 + row) * NPROJ + C_GMV + g * 128 + c16 * 8);
        uraw[k] = *(const GAS v4u*)(P.PROJ + (size_t)(T0 + row) * NPROJ + C_GMU + g * 128 + c16 * 8);
        bsv[k] = P.gmb[g * 128 + row]; }
    bf16x8 Af[8];
    { const float* Wrow = P.gws + ((size_t)g * 128 + trow) * 128;
#pragma unroll
      for (int ks = 0; ks < 8; ++ks) { const int s0 = 16 * ks + 8 * h;
          const f32x4 wa = *(const GAS f32x4*)(Wrow + s0), wb = *(const GAS f32x4*)(Wrow + s0 + 4);
          float w[8] = {wa.x, wa.y, wa.z, wa.w, wb.x, wb.y, wb.z, wb.w};
#pragma unroll
          for (int j = 0; j < 8; ++j) w[j] = (s0 + j <= trow) ? w[j] : 0.f;
          Af[ks] = __builtin_bit_cast(bf16x8, pack8(w)); } }
#pragma unroll
    for (int k = 0; k < 4; ++k) {
        const int id = tid + 512 * k, row = id >> 4, c16 = id & 15;
        float x[8]; unpack8(vraw[k], x);
        float ss = 0.f;
#pragma unroll
        for (int j = 0; j < 8; ++j) { x[j] = gelu_f(x[j]); ss += x[j] * x[j]; }
        ss += sx(ss, 1); ss += sx(ss, 2); ss += sx(ss, 4); ss += sx(ss, 8);
        const float rs = 1.0f / sqrtf(ss * (1.0f / 128.0f) + EPS);
        const float* vg = P.vng + g * 128 + c16 * 8;
#pragma unroll
        for (int j = 0; j < 8; ++j) x[j] = x[j] * rs * vg[j];
        *(LAS v4u*)(Vn + row * 136 + c16 * 8) = pack8(x);
    }
    __syncthreads();
    f32x16 acc0 = {}, acc1 = {};
#pragma unroll
    for (int ks = 0; ks < 8; ++ks) {
        if (ks < 2 * (ti + 1)) {
            const int s0 = 16 * ks + 8 * h;
            const LAS bf16* bp = Vn + (s0 + q) * 136 + 32 * dj0 + 16 * nh + 4 * p;
            const bf16x8 B0 = mk8(tr16(bp), tr16(bp + 4 * 136)), B1 = mk8(tr16(bp + 32), tr16(bp + 32 + 4 * 136));
            acc0 = MFMA32(Af[ks], B0, acc0); acc1 = MFMA32(Af[ks], B1, acc1);
        }
    }
    LAS float* Zs = (LAS float*)(lds + 36864);
#pragma unroll
    for (int rg = 0; rg < 16; ++rg) { const int t = 32 * ti + crow(rg, h); Zs[t * 132 + 32 * dj0 + r] = acc0[rg]; Zs[t * 132 + 32 * dj0 + 32 + r] = acc1[rg]; }
    __syncthreads();
#pragma unroll
    for (int k = 0; k < 4; ++k) {
        const int id = tid + 512 * k, row = id >> 4, c16 = id & 15;
        float uu[8]; unpack8(uraw[k], uu);
        const f32x4 za = *(const LAS f32x4*)(Zs + row * 132 + c16 * 8), zb = *(const LAS f32x4*)(Zs + row * 132 + c16 * 8 + 4);
        const float z[8] = {za.x, za.y, za.z, za.w, zb.x, zb.y, zb.z, zb.w};
#pragma unroll
        for (int j = 0; j < 8; ++j) uu[j] = gelu_f(uu[j]) * (z[j] + bsv[k]);
        *(GAS v4u*)(P.MIX + (size_t)(T0 + row) * 2048 + g * 128 + c16 * 8) = pack8(uu);
    }
    __syncthreads();
}

__device__ __forceinline__ void mlstm_unit(int u, int l, const Args& args, LAS unsigned char* lds, int tid_in, int wave, int lane_in) {
    const MixP P = make_mixp(args, l);
    int tid = tid_in; asm volatile("" : "+v"(tid)); const int lane = tid & 63; (void)lane_in;
    const int b = u / 6, hd = u % 6; const size_t rowbase = (size_t)b * SEQ;
    LAS bf16* Qs = (LAS bf16*)lds;
    LAS bf16* Ks = (LAS bf16*)(lds + 18432);
    LAS bf16* Hs = (LAS bf16*)lds;
    LAS float* npart = (LAS float*)(lds + 36864);
    LAS bf16* Vs = (LAS bf16*)(lds + 55296);
    LAS bf16* Ct = (LAS bf16*)(lds + 90112);
    LAS float* beta = (LAS float*)(lds + 108544); LAS float* alpha = beta + 128; LAS float* winter = beta + 256; LAS float* thr = beta + 384; LAS float* wupd = beta + 512;
    LAS float* nst = beta + 640; LAS float* scal = beta + 704;
    const int r = lane & 31, h = lane >> 5, q = (lane & 15) >> 2, p = lane & 3, nh = (lane >> 4) & 1;
    f32x16 Cacc = {};
    for (int i = tid; i < 128 * 72 / 2; i += 512) ((LAS unsigned*)Ct)[i] = 0u;
    if (tid < 64) nst[tid] = 0.f;
    float m_st = 0.f;
    const float igb = P.igb[hd], fgb = P.fgb[hd];
    LAS float* g_be = (LAS float*)(lds + 114688); LAS float* g_b = g_be + 2048; LAS float* g_cm = g_be + 4096;
    LAS float* ngl = g_be + 6144;
    if (tid < 128) ngl[tid] = P.mlng[hd * 128 + tid];
    LAS float* cwl = ngl + 128; LAS float* cbl = cwl + 512;
    cwl[tid] = P.convw[(tid >> 7) * 768 + ((tid >> 6) & 1) * 384 + hd * 64 + (tid & 63)];
    if (tid < 128) cbl[tid] = P.convb[(tid >> 6) * 384 + hd * 64 + (tid & 63)];
#pragma unroll 1
    for (int cc = wave; cc < 16; cc += 8) {
        const size_t Tg = rowbase + (size_t)cc * 128; const int i0 = 2 * lane;
        const float ig0 = P.GATES[(Tg + i0) * 16 + hd] + igb, ig1 = P.GATES[(Tg + i0 + 1) * 16 + hd] + igb;
        const float f0 = P.GATES[(Tg + i0) * 16 + 6 + hd] + fgb, f1 = P.GATES[(Tg + i0 + 1) * 16 + 6 + hd] + fgb;
        const float lf0 = fminf(f0, 0.f) - log1pf(__expf(-fabsf(f0))), lf1 = fminf(f1, 0.f) - log1pf(__expf(-fabsf(f1)));
        float sc = lf0 + lf1;
#pragma unroll
        for (int o = 1; o < 64; o <<= 1) { const float tt = sup(sc, o); if (lane >= o) sc += tt; }
        const float b1 = sc, b0 = sc - lf1;
        const float be0 = ig0 - b0, be1 = ig1 - b1;
        float mx = fmaxf(be0, be1);
#pragma unroll
        for (int o = 1; o < 64; o <<= 1) { const float tt = sup(mx, o); if (lane >= o) mx = fmaxf(mx, tt); }
        float prev = sup(mx, 1); if (lane == 0) prev = -INFINITY;
        const float cm0 = fmaxf(prev, be0), cm1 = mx;
        g_be[cc * 128 + i0] = be0; g_be[cc * 128 + i0 + 1] = be1; g_b[cc * 128 + i0] = b0; g_b[cc * 128 + i0 + 1] = b1; g_cm[cc * 128 + i0] = cm0; g_cm[cc * 128 + i0 + 1] = cm1;
    }
    __syncthreads();
#pragma unroll 1
    for (int c = 0; c < 16; ++c) {
        const size_t T0 = rowbase + (size_t)c * 128;
        if (tid < 128) {
            const float be = g_be[c * 128 + tid], bb = g_b[c * 128 + tid], cm = g_cm[c * 128 + tid], cm_end = g_cm[c * 128 + 127], b_end = g_b[c * 128 + 127];
            const float al = -fmaxf(m_st, cm), a_end = -fmaxf(m_st, cm_end);
            beta[tid] = be; alpha[tid] = al; winter[tid] = __expf(m_st + al); thr[tid] = __expf(al - bb); wupd[tid] = __expf(be + a_end);
            if (tid == 0) { scal[0] = __expf(m_st + a_end); scal[1] = b_end - a_end; }
        }
        v4u vraw[4], xt[2][2][4];
#pragma unroll
        for (int k = 0; k < 4; ++k) { const int id = tid + 512 * k, row = id >> 4, c16 = id & 15; vraw[k] = *(const GAS v4u*)(P.PROJ + (T0 + row) * NPROJ + C_MLV + hd * 128 + c16 * 8); }
#define ML_TAPS(qk_, k_) do { const int id = tid + 512 * (k_), row = id >> 3, c8 = id & 7; \
            const bf16* src = P.PROJ + (T0 + row) * NPROJ + ((qk_) ? C_MLK : C_MLQ) + hd * 64 + c8 * 8; \
            _Pragma("unroll") for (int j = 0; j < 4; ++j) { const int srow = c * 128 + row - 3 + j; xt[qk_][k_][j] = *(const GAS v4u*)(src + (long)((srow >= 0) ? (j - 3) : 0) * NPROJ); } } while (0)
        ML_TAPS(0, 0); ML_TAPS(0, 1); ML_TAPS(1, 0); ML_TAPS(1, 1);
#pragma unroll
        for (int k = 0; k < 4; ++k) { const int id = tid + 512 * k, row = id >> 4, c16 = id & 15; *(LAS v4u*)(Vs + row * 136 + c16 * 8) = vraw[k]; }
#undef ML_TAPS
#pragma unroll
        for (int qk = 0; qk < 2; ++qk) {
#pragma unroll
            for (int k = 0; k < 2; ++k) {
                const int id = tid + 512 * k, row = id >> 3; int c8 = id & 7; asm volatile("" : "+v"(c8));
                float y[8];
                { const f32x4 ba = *(const LAS f32x4*)(cbl + qk * 64 + c8 * 8), bb = *(const LAS f32x4*)(cbl + qk * 64 + c8 * 8 + 4); y[0] = ba.x; y[1] = ba.y; y[2] = ba.z; y[3] = ba.w; y[4] = bb.x; y[5] = bb.y; y[6] = bb.z; y[7] = bb.w; }
#pragma unroll
                for (int j = 0; j < 4; ++j) {
                    const int srow = c * 128 + row - 3 + j; const float msk = (srow >= 0) ? 1.0f : 0.0f;
                    float x[8]; unpack8(xt[qk][k][j], x);
                    const f32x4 wa = *(const LAS f32x4*)(cwl + (j * 2 + qk) * 64 + c8 * 8) * msk, wb = *(const LAS f32x4*)(cwl + (j * 2 + qk) * 64 + c8 * 8 + 4) * msk;
                    y[0] += wa.x * x[0]; y[1] += wa.y * x[1]; y[2] += wa.z * x[2]; y[3] += wa.w * x[3]; y[4] += wb.x * x[4]; y[5] += wb.y * x[5]; y[6] += wb.z * x[6]; y[7] += wb.w * x[7];
                }
                if (qk == 0) {
#pragma unroll
                    for (int jj = 0; jj < 8; ++jj) y[jj] = silu_f(y[jj]);
                    *(LAS v4u*)(Qs + row * 72 + c8 * 8) = pack8(y);
                } else {
#pragma unroll
                    for (int jj = 0; jj < 8; ++jj) y[jj] = silu_f(y[jj]) * 0.125f;
                    *(LAS v4u*)(Ks + row * 72 + c8 * 8) = pack8(y);
                }
            }
        }
        __syncthreads();
        const int ib = wave >> 1, dvh = wave & 1, iabs = 32 * ib + r;
        const float al_i = alpha[iabs], wi_i = winter[iabs], th_i = thr[iabs];
        bf16x8 Bq[4];
#pragma unroll
        for (int ks = 0; ks < 4; ++ks) Bq[ks] = *(const LAS bf16x8*)(Qs + iabs * 72 + 16 * ks + 8 * h);
        f32x16 num0 = {}, num1 = {}; float den = 0.f;
        for (int sb = 0; sb <= ib; ++sb) {
            f32x16 X = {};
#pragma unroll
            for (int ks = 0; ks < 4; ++ks) { const bf16x8 Ak = *(const LAS bf16x8*)(Ks + (32 * sb + r) * 72 + 16 * ks + 8 * h); X = MFMA32(Ak, Bq[ks], X); }
#pragma unroll
            for (int rg = 0; rg < 16; ++rg) { const int sabs = 32 * sb + crow(rg, h); const float w = (sabs <= iabs) ? __expf(al_i + beta[sabs]) : 0.f; X[rg] *= w; den += X[rg]; }
#pragma unroll
            for (int st = 0; st < 2; ++st) {
                v4u pw; pw.x = pk2(X[8 * st], X[8 * st + 1]); pw.y = pk2(X[8 * st + 2], X[8 * st + 3]); pw.z = pk2(X[8 * st + 4], X[8 * st + 5]); pw.w = pk2(X[8 * st + 6], X[8 * st + 7]);
                const bf16x8 Bs = __builtin_bit_cast(bf16x8, pw);
                const LAS bf16* vp = Vs + (32 * sb + 16 * st + 4 * h + q) * 136 + 64 * dvh + 16 * nh + 4 * p;
                const bf16x8 A0 = mk8(tr16(vp), tr16(vp + 8 * 136)), A1 = mk8(tr16(vp + 32), tr16(vp + 32 + 8 * 136));
                num0 = MFMA32(A0, Bs, num0); num1 = MFMA32(A1, Bs, num1);
            }
        }
        f32x16 in0 = {}, in1 = {};
#pragma unroll
        for (int ks = 0; ks < 4; ++ks) {
            const bf16x8 A0 = *(const LAS bf16x8*)(Ct + (64 * dvh + r) * 72 + 16 * ks + 8 * h), A1 = *(const LAS bf16x8*)(Ct + (64 * dvh + 32 + r) * 72 + 16 * ks + 8 * h);
            in0 = MFMA32(A0, Bq[ks], in0); in1 = MFMA32(A1, Bq[ks], in1);
        }
        float qn = 0.f;
#pragma unroll
        for (int k4 = 0; k4 < 4; ++k4) { float x[8]; unpack8(*(const LAS v4u*)(Qs + iabs * 72 + 32 * h + 8 * k4), x);
#pragma unroll
            for (int j = 0; j < 8; ++j) qn += x[j] * nst[32 * h + 8 * k4 + j]; }
        qn += sx(qn, 32); den += sx(den, 32);
        const float dtot = den + wi_i * qn, hsc = 1.0f / fmaxf(fabsf(dtot), th_i);
#pragma unroll
        for (int rg = 0; rg < 16; ++rg) { num0[rg] = (num0[rg] + wi_i * in0[rg]) * hsc; num1[rg] = (num1[rg] + wi_i * in1[rg]) * hsc; }
        const int dvt = wave >> 1, dkt = wave & 1; const float decay = scal[0], m_new = scal[1];
#pragma unroll
        for (int rg = 0; rg < 16; ++rg) Cacc[rg] *= decay;
#pragma unroll
        for (int ks = 0; ks < 8; ++ks) {
            const LAS bf16* vp = Vs + (16 * ks + 8 * h + q) * 136 + 32 * dvt + 16 * nh + 4 * p;
            const LAS bf16* kp = Ks + (16 * ks + 8 * h + q) * 72 + 32 * dkt + 16 * nh + 4 * p;
            const s16x4 va = tr16(vp), vb = tr16(vp + 4 * 136);
            const f32x4 wa = *(const LAS f32x4*)(wupd + 16 * ks + 8 * h), wb = *(const LAS f32x4*)(wupd + 16 * ks + 8 * h + 4);
            v4u aw; aw.x = pk2(bf2f((unsigned short)va[0]) * wa.x, bf2f((unsigned short)va[1]) * wa.y); aw.y = pk2(bf2f((unsigned short)va[2]) * wa.z, bf2f((unsigned short)va[3]) * wa.w);
            aw.z = pk2(bf2f((unsigned short)vb[0]) * wb.x, bf2f((unsigned short)vb[1]) * wb.y); aw.w = pk2(bf2f((unsigned short)vb[2]) * wb.z, bf2f((unsigned short)vb[3]) * wb.w);
            const bf16x8 Av = __builtin_bit_cast(bf16x8, aw), Bk = mk8(tr16(kp), tr16(kp + 4 * 72));
            Cacc = MFMA32(Av, Bk, Cacc);
        }
        { float ps = 0.f;
#pragma unroll
            for (int s8 = 0; s8 < 16; ++s8) ps += wupd[16 * wave + s8] * bf2f(Ks[(16 * wave + s8) * 72 + lane]);
            npart[wave * 64 + lane] = ps; }
        v4u ogate[4];
        { const bf16* op = P.PROJ + (T0 + (tid >> 2)) * NPROJ + C_MLO + hd * 128 + (tid & 3) * 32;
#pragma unroll
            for (int k = 0; k < 4; ++k) ogate[k] = *(const GAS v4u*)(op + k * 8); }
        __syncthreads();
#pragma unroll
        for (int g4 = 0; g4 < 4; ++g4) {
            v2u w0; w0.x = pk2(num0[4 * g4], num0[4 * g4 + 1]); w0.y = pk2(num0[4 * g4 + 2], num0[4 * g4 + 3]);
            v2u w1; w1.x = pk2(num1[4 * g4], num1[4 * g4 + 1]); w1.y = pk2(num1[4 * g4 + 2], num1[4 * g4 + 3]);
            *(LAS v2u*)(Hs + iabs * 136 + 64 * dvh + 8 * g4 + 4 * h) = w0; *(LAS v2u*)(Hs + iabs * 136 + 64 * dvh + 32 + 8 * g4 + 4 * h) = w1;
        }
#pragma unroll
        for (int rg = 0; rg < 16; ++rg) Ct[(32 * dvt + crow(rg, h)) * 72 + 32 * dkt + r] = (bf16)f2bf(Cacc[rg]);
        if (tid < 64) { float s = 0.f;
#pragma unroll
            for (int w8 = 0; w8 < 8; ++w8) s += npart[w8 * 64 + tid];
            nst[tid] = decay * nst[tid] + s; }
        m_st = m_new;
        __syncthreads();
        {
            const int row = tid >> 2, part = tid & 3; float v[32];
#pragma unroll
            for (int k = 0; k < 4; ++k) { float x[8]; unpack8(*(const LAS v4u*)(Hs + row * 136 + part * 32 + k * 8), x);
#pragma unroll
                for (int j = 0; j < 8; ++j) v[k * 8 + j] = x[j]; }
            float ss = 0.f;
#pragma unroll
            for (int j = 0; j < 32; ++j) ss += v[j] * v[j];
            ss += sx(ss, 1); ss += sx(ss, 2);
            const float rs = 1.0f / sqrtf(ss * (1.0f / 128.0f) + EPS);
            const LAS float* ng = ngl + part * 32;
            bf16* mp = P.MIX + (T0 + row) * 2048 + 512 + hd * 128 + part * 32;
#pragma unroll
            for (int k = 0; k < 4; ++k) { float o[8], y[8]; unpack8(ogate[k], o);
#pragma unroll
                for (int j = 0; j < 8; ++j) y[j] = v[k * 8 + j] * rs * ng[k * 8 + j] * sigmoid_f(o[j]);
                *(GAS v4u*)(mp + k * 8) = pack8(y); }
        }
        __syncthreads();
    }
}

__device__ __forceinline__ void dattn_unit(int u, int l, const Args& args, unsigned char* shm, int wave, int lane_in) {
    const MixP P = make_mixp(args, l);
    int lane = lane_in; asm volatile("" : "+v"(lane));
    const int qb = 7 - u / 96, bh = u % 96, b = bh / 6, hd = bh % 6;
    const size_t rowbase = (size_t)b * SEQ; const int q0 = qb * 256;
    const float la = P.lamp[lane] * P.lamp[64 + lane], lb = P.lamp[128 + lane] * P.lamp[192 + lane];
    const float lam = __builtin_bit_cast(float, __builtin_amdgcn_readfirstlane(__builtin_bit_cast(int, __expf(wave_sum(la)) - __expf(wave_sum(lb)) + P.lambda_init)));
    typedef attn_body::bf16 abf;
#pragma unroll 1
    for (int run = 0; run < 4; ++run) {
        const int m = __builtin_amdgcn_readfirstlane(run >> 1), f = __builtin_amdgcn_readfirstlane(run & 1);
        const abf* Qw0 = (const abf*)P.PROJ + (rowbase + q0) * NPROJ + C_DAQ + (hd * 2 + m) * 64;
        const abf* Kh = (const abf*)P.PROJ + rowbase * NPROJ + C_DAK + (hd * 2 + m) * 64;
        const abf* Vh = (const abf*)P.PROJ + rowbase * NPROJ + C_DAV + hd * 128 + f * 64;
        attn_body::attn_run<8>(Qw0, Kh, Vh, q0, (char*)shm, m, f * 64, lam, wave);
    }
    const LAS bf16* hold = (const LAS bf16*)((LAS unsigned char*)shm + attn_body::LDS_HOLD) + wave * 4096;
    const int row = lane >> 1, half = lane & 1;
    float ss = 0.f;
#pragma unroll
    for (int k = 0; k < 8; ++k) { float x[8]; unpack8(*(const LAS v4u*)(hold + row * 128 + half * 64 + k * 8), x);
#pragma unroll
        for (int j = 0; j < 8; ++j) ss += x[j] * x[j]; }
    ss += sx(ss, 1);
    const float sc = (1.0f - P.lambda_init) / sqrtf(ss * (1.0f / 128.0f) + EPS);
    bf16* mp = P.MIX + (rowbase + q0 + wave * 32 + row) * 2048 + 1280 + hd * 128 + half * 64; const float* sg = P.subg + half * 64;
#pragma unroll
    for (int k = 0; k < 8; ++k) { float x[8]; unpack8(*(const LAS v4u*)(hold + row * 128 + half * 64 + k * 8), x);
#pragma unroll
        for (int j = 0; j < 8; ++j) x[j] = x[j] * sc * sg[k * 8 + j];
        *(GAS v4u*)(mp + k * 8) = pack8(x); }
    LDS_WAIT();
    __syncthreads();
}

namespace da2 {
constexpr int STAGE = 32768, NST = 4;
__device__ __forceinline__ void glds16(const void* gsrc, unsigned lds_dst) { unsigned keep;
    asm volatile("s_mov_b32 %0, m0\n\ts_mov_b32 m0, %2\n\ts_nop 0\n\tglobal_load_lds_dwordx4 %1, off\n\ts_mov_b32 m0, %0" : "=&s"(keep) : "v"(gsrc), "s"(lds_dst) : "memory"); }
#define DA2_WAIT_BAR(N) asm volatile("s_waitcnt vmcnt(" #N ") lgkmcnt(0)\n\ts_barrier" ::: "memory")
__device__ __forceinline__ float swap_max(float v) { auto rr = __builtin_amdgcn_permlane32_swap(__float_as_uint(v), __float_as_uint(v), false, false); return fmaxf(__uint_as_float(rr[0]), __uint_as_float(rr[1])); }
__device__ __forceinline__ float swap_add(float v) { auto rr = __builtin_amdgcn_permlane32_swap(__float_as_uint(v), __float_as_uint(v), false, false); return __uint_as_float(rr[0]) + __uint_as_float(rr[1]); }
__device__ __forceinline__ float max3f(float a, float b, float c) { float r; asm("v_max3_f32 %0, %1, %2, %3" : "=v"(r) : "v"(a), "v"(b), "v"(c)); return r; }
__device__ __forceinline__ float max16(const f32x16& c) { float r;
    asm("v_max3_f32 %0, %1, %2, %3\n\tv_max3_f32 %0, %0, %4, %5\n\tv_max3_f32 %0, %0, %6, %7\n\tv_max3_f32 %0, %0, %8, %9\n\tv_max3_f32 %0, %0, %10, %11\n\tv_max3_f32 %0, %0, %12, %13\n\tv_max3_f32 %0, %0, %14, %15\n\tv_max3_f32 %0, %0, %16, %16"
        : "=&v"(r) : "v"(c[0]), "v"(c[1]), "v"(c[2]), "v"(c[3]), "v"(c[4]), "v"(c[5]), "v"(c[6]), "v"(c[7]), "v"(c[8]), "v"(c[9]), "v"(c[10]), "v"(c[11]), "v"(c[12]), "v"(c[13]), "v"(c[14]), "v"(c[15]));
    return r; }

__device__ __forceinline__ void unit(int u, const MixP& P, LAS unsigned char* lds, int wave, int lane_in) {
    int lane = lane_in; asm volatile("" : "+v"(lane));
    const int pfl = PROBE_REP >= 0 ? karg_flags() : 0;
    const int qi = 15 - u / 96, bh = u % 96, b = bh / 6, hd = bh % 6;
    const size_t T0 = (size_t)b * SEQ; const int q0 = qi * 128, NT = (pfl & 16384) ? 2 : 2 * (qi + 1);
    const int map = wave >> 2, wq = wave & 3, r32 = lane & 31, hi = lane >> 5, q4 = (lane & 15) >> 2, p4 = lane & 3, nh = (lane >> 4) & 1;
    const unsigned lds0 = (unsigned)(unsigned long long)lds;
    const float lam = *(const LAS float*)(lds + MISC_OFF + 24);
    const int krow = 8 * wave + (lane >> 3), kx7 = (krow >> 1) & 7, kx1 = (krow >> 1) & 1;
    const bf16* ksrc0 = P.PROJ + (T0 + krow) * NPROJ + C_DAK + hd * 128 + 8 * ((lane & 7) ^ kx7), *ksrc1 = ksrc0 + 64;
    const bf16* vsrc0 = P.PROJ + (T0 + krow) * NPROJ + C_DAV + hd * 128 + 32 * (((lane & 7) >> 2) ^ kx1) + 8 * (lane & 3), *vsrc1 = vsrc0 + 64;
    const unsigned kd0 = lds0 + wave * 1024, kd1 = kd0 + 8192, vd0 = lds0 + 16384 + wave * 1024, vd1 = vd0 + 8192;
#define DA2_DMA(t_, st_) do { const size_t go_ = (size_t)(t_) * 64 * NPROJ; const unsigned so_ = (unsigned)(st_) * STAGE; \
        glds16(ksrc0 + go_, (unsigned)__builtin_amdgcn_readfirstlane(kd0 + so_)); glds16(ksrc1 + go_, (unsigned)__builtin_amdgcn_readfirstlane(kd1 + so_)); \
        glds16(vsrc0 + go_, (unsigned)__builtin_amdgcn_readfirstlane(vd0 + so_)); glds16(vsrc1 + go_, (unsigned)__builtin_amdgcn_readfirstlane(vd1 + so_)); } while (0)
    DA2_DMA(0, 0); DA2_DMA(1, 1); if (NT > 2) DA2_DMA(2, 2);
    bf16x8 qr[4];
    { const bf16* qp = P.PROJ + (T0 + q0 + wq * 32 + r32) * NPROJ + C_DAQ + (hd * 2 + map) * 64 + 8 * hi;
#pragma unroll
      for (int ds = 0; ds < 4; ++ds) qr[ds] = *(const GAS bf16x8*)(qp + 16 * ds); }
    f32x16 o0 = {}, o1 = {}, o2 = {}, o3 = {};
    const int qabs = q0 + wq * 32 + r32, qmin = q0 + wq * 32;
    const LAS unsigned char* kfb = lds + map * 8192 + r32 * 128;
    int kof[4];
#pragma unroll
    for (int ds = 0; ds < 4; ++ds) kof[ds] = ((2 * ds + hi) ^ ((r32 >> 1) & 7)) * 16;
    const int vxa = ((q4 >> 1) & 1) * 64, vxb = 64 - vxa;
    const LAS unsigned char* vfb = lds + 16384 + (4 * hi + q4) * 128 + 32 * nh + 8 * p4;
#define DA2_QK(P0_, P1_, C_, stg_) do { const LAS unsigned char* kf_ = kfb + (stg_) * STAGE; bf16x8 ka_[4], kb_[4]; \
        _Pragma("unroll") for (int ds = 0; ds < 4; ++ds) ka_[ds] = *(const LAS bf16x8*)(kf_ + kof[ds]); \
        _Pragma("unroll") for (int ds = 0; ds < 4; ++ds) kb_[ds] = *(const LAS bf16x8*)(kf_ + kof[ds] + 4096); \
        P0_ = MFMA32(ka_[0], qr[0], C_); P1_ = MFMA32(kb_[0], qr[0], C_); \
        _Pragma("unroll") for (int ds = 1; ds < 4; ++ds) { P0_ = MFMA32(ka_[ds], qr[ds], P0_); P1_ = MFMA32(kb_[ds], qr[ds], P1_); } \
        __builtin_amdgcn_sched_group_barrier(0x100, 8, 0); __builtin_amdgcn_sched_group_barrier(0x008, 8, 0); } while (0)
#define DA2_SPLAT(P_, v_) do { _Pragma("unroll") for (int rg = 0; rg < 16; ++rg) P_[rg] = (v_); } while (0)
    if (NT > 2) DA2_WAIT_BAR(8); else DA2_WAIT_BAR(4);
    float m_run = 0.f, l_run = 0.f; float ninf = -INFINITY; asm volatile("" : "+v"(ninf));
    f32x16 negm = {}, sa0, sa1, sb0, sb1; DA2_QK(sa0, sa1, negm, 0);
    if (map == 1) __builtin_amdgcn_s_setprio(1);
    int st = 0;
#define DA2_STEP(t_, C0_, C1_, N0_, N1_) do { const int tt_ = (t_); \
        const int st1 = (st == 3) ? 0 : st + 1; \
        if (tt_ + 2 < NT) DA2_WAIT_BAR(4); else DA2_WAIT_BAR(0);                     \
        if (tt_ + 3 < NT) { const int s3 = (st == 0) ? 3 : st - 1; DA2_DMA(tt_ + 3, s3); }     \
        if (!(pfl & 8192)) DA2_QK(N0_, N1_, negm, st1);                                    \
        if (64 * tt_ <= qmin + 31) {                                                 \
            const LAS unsigned char* vf = vfb + st * STAGE; \
            if (64 * tt_ + 63 > qmin) {                                              \
                _Pragma("unroll") for (int rg = 0; rg < 16; ++rg) { const int ka = 64 * tt_ + crow(rg, hi); if (ka > qabs) C0_[rg] = ninf; if (ka + 32 > qabs) C1_[rg] = ninf; } \
            } \
            if (!(pfl & 2048)) { \
            const float mxa_ = max16(C0_), mxb_ = max16(C1_); \
            const float mx = swap_max(max3f(mxa_, mxb_, mxb_)); \
            if (tt_ == 0 || __any(mx > 6.0f)) {                                      \
                const float d_ = (tt_ == 0) ? mx : fmaxf(mx, 0.f); const float al = (tt_ == 0) ? 1.f : __builtin_amdgcn_exp2f(-d_); l_run *= al; m_run += d_; \
                _Pragma("unroll") for (int rg = 0; rg < 16; ++rg) { o0[rg] *= al; o1[rg] *= al; o2[rg] *= al; o3[rg] *= al; C0_[rg] -= d_; C1_[rg] -= d_; N0_[rg] -= d_; N1_[rg] -= d_; } \
                DA2_SPLAT(negm, -m_run); } \
            float rs = 0.f; \
            _Pragma("unroll") for (int rg = 0; rg < 16; ++rg) { C0_[rg] = __builtin_amdgcn_exp2f(C0_[rg]); rs += C0_[rg]; C1_[rg] = __builtin_amdgcn_exp2f(C1_[rg]); rs += C1_[rg]; } \
            l_run += rs; \
            } \
            bf16x8 pf[4]; \
            { v4u w; w.x = pk2(C0_[0], C0_[1]); w.y = pk2(C0_[2], C0_[3]); w.z = pk2(C0_[4], C0_[5]); w.w = pk2(C0_[6], C0_[7]); pf[0] = __builtin_bit_cast(bf16x8, w); \
              w.x = pk2(C0_[8], C0_[9]); w.y = pk2(C0_[10], C0_[11]); w.z = pk2(C0_[12], C0_[13]); w.w = pk2(C0_[14], C0_[15]); pf[1] = __builtin_bit_cast(bf16x8, w); \
              w.x = pk2(C1_[0], C1_[1]); w.y = pk2(C1_[2], C1_[3]); w.z = pk2(C1_[4], C1_[5]); w.w = pk2(C1_[6], C1_[7]); pf[2] = __builtin_bit_cast(bf16x8, w); \
              w.x = pk2(C1_[8], C1_[9]); w.y = pk2(C1_[10], C1_[11]); w.z = pk2(C1_[12], C1_[13]); w.w = pk2(C1_[14], C1_[15]); pf[3] = __builtin_bit_cast(bf16x8, w); } \
            if (!(pfl & 4096)) \
            _Pragma("unroll") for (int s = 0; s < 4; ++s) { \
                const LAS bf16* va_ = (const LAS bf16*)(vf + s * 2048 + vxa); const LAS bf16* vb_ = (const LAS bf16*)(vf + s * 2048 + vxb); \
                const bf16x8 a0 = mk8(tr16(va_), tr16(va_ + 512)), a1 = mk8(tr16(vb_), tr16(vb_ + 512)), a2 = mk8(tr16(va_ + 4096), tr16(va_ + 4096 + 512)), a3 = mk8(tr16(vb_ + 4096), tr16(vb_ + 4096 + 512)); \
                o0 = MFMA32(a0, pf[s], o0); o1 = MFMA32(a1, pf[s], o1); o2 = MFMA32(a2, pf[s], o2); o3 = MFMA32(a3, pf[s], o3); \
            } \
        } \
        st = st1; } while (0)
#pragma unroll 1
    for (int t = 0; t < NT; t += 2) {
        DA2_STEP(t, sa0, sa1, sb0, sb1);
        DA2_STEP(t + 1, sb0, sb1, sa0, sa1);
    }
#undef DA2_STEP
#undef DA2_SPLAT
#undef DA2_QK
    __builtin_amdgcn_s_setprio(0);
    unsigned pre_ = 0u; const bool t0_ = (wave == 0) && (lane == 0);
    if (t0_) { unsigned* hp_ = (unsigned*)*(const LAS unsigned long long*)(lds + MISC_OFF + 32); pre_ = __hip_atomic_fetch_add(hp_, 1u, RLX_AGENT); }
    f32x4 sg[4][4];
    if (map == 0) {
#pragma unroll
        for (int g = 0; g < 4; ++g)
#pragma unroll
            for (int j = 0; j < 4; ++j) sg[g][j] = *(const GAS f32x4*)(P.subg + 32 * j + 8 * g + 4 * hi);
    }
#define DA2_LBAR() asm volatile("s_waitcnt lgkmcnt(0)\n\ts_barrier" ::: "memory")
    { const float inv = 1.0f / swap_add(l_run);
#pragma unroll
      for (int rg = 0; rg < 16; ++rg) { o0[rg] *= inv; o1[rg] *= inv; o2[rg] *= inv; o3[rg] *= inv; } }
    DA2_LBAR();
    LAS float* xb = (LAS float*)lds + wq * 4096 + lane;
    if (map == 1) {
#pragma unroll
        for (int rg = 0; rg < 16; ++rg) { xb[rg * 64] = o0[rg]; xb[(16 + rg) * 64] = o1[rg]; xb[(32 + rg) * 64] = o2[rg]; xb[(48 + rg) * 64] = o3[rg]; }
    }
    DA2_LBAR();
    if (map == 0) {
        float ss = 0.f;
#pragma unroll
        for (int rg = 0; rg < 16; ++rg) { o0[rg] -= lam * xb[rg * 64]; o1[rg] -= lam * xb[(16 + rg) * 64]; o2[rg] -= lam * xb[(32 + rg) * 64]; o3[rg] -= lam * xb[(48 + rg) * 64];
            ss += o0[rg] * o0[rg] + o1[rg] * o1[rg] + o2[rg] * o2[rg] + o3[rg] * o3[rg]; }
        ss = swap_add(ss);
        const float sc = (1.0f - P.lambda_init) / sqrtf(ss * (1.0f / 128.0f) + EPS);
        bf16* mp = P.MIX + (T0 + qabs) * 2048 + 1280 + hd * 128 + 8 * hi;
#define DA2_PK(o_, g_, s_) (v2u){pk2(o_[4 * (g_)] * sc * s_.x, o_[4 * (g_) + 1] * sc * s_.y), pk2(o_[4 * (g_) + 2] * sc * s_.z, o_[4 * (g_) + 3] * sc * s_.w)}
#define DA2_ST16(o_, j_, g_) do { v2u a_ = DA2_PK(o_, g_, sg[g_][j_]), b_ = DA2_PK(o_, (g_) + 1, sg[(g_) + 1][j_]); \
            auto rx_ = __builtin_amdgcn_permlane32_swap(a_.x, b_.x, false, false); auto ry_ = __builtin_amdgcn_permlane32_swap(a_.y, b_.y, false, false); \
            v4u w_; w_.x = rx_[0]; w_.y = ry_[0]; w_.z = rx_[1]; w_.w = ry_[1]; *(GAS v4u*)(mp + 32 * (j_) + 8 * (g_)) = w_; } while (0)
#pragma unroll
        for (int g = 0; g < 4; g += 2) { DA2_ST16(o0, 0, g); DA2_ST16(o1, 1, g); DA2_ST16(o2, 2, g); DA2_ST16(o3, 3, g); }
#undef DA2_ST16
#undef DA2_PK
    }
    if (t0_) *(volatile LAS unsigned*)(lds + MISC_OFF + 28) = pre_ + 1u;
    DA2_LBAR();
#undef DA2_DMA
#undef DA2_LBAR
}
#undef DA2_WAIT_BAR
}

constexpr int NPHASE = 9 * NLAYER + 1;
#ifndef PHASE_MASK
#define PHASE_MASK 0x3ff
#endif
#define EN(k) (((PHASE_MASK) >> (k)) & 1)
#ifndef ABL_FLAGS
#define ABL_FLAGS 0
#endif
#if ABL_FLAGS
#define ABL_OFF(bit) (!(karg_flags() & (bit)))
#else
#define ABL_OFF(bit) true
#endif
#ifndef PROBE_REP
#define PROBE_REP -1
#endif
#ifndef ATT_V1
#define NATT 1536
#define ATT_UNIT(v) do { const MixP P_ = make_mixp(args, l); da2::unit((v), P_, lds, wave, lane_o); } while (0)
#else
#define NATT 768
#define ATT_UNIT(v) dattn_unit((v), l, args, lds_, wave, lane_o)
#endif
#ifndef PROBE_SKIP
#define PROBE_SKIP 0
#endif
#ifndef PROBE_LAYER
#define PROBE_LAYER 0
#endif
#ifndef UNIT_MASK
#define UNIT_MASK 7
#endif
#define UEN(k) (((UNIT_MASK) >> (k)) & 1)
__device__ __forceinline__ void zero_tile(bf16* MIX, int row0, int nrows, int col0, int tid) {
    for (int i = tid; i < nrows * 16; i += 512) *(GAS v4u*)(MIX + (size_t)(row0 + (i >> 4)) * 2048 + col0 + (i & 15) * 8) = (v4u){0u, 0u, 0u, 0u};
}
__global__ void __launch_bounds__(512, 2) hybrid_fwd(Args args) {
    extern __shared__ __attribute__((aligned(16))) unsigned char lds_[];
    LAS unsigned char* lds = (LAS unsigned char*)lds_;
    const int wave = __builtin_amdgcn_readfirstlane((int)threadIdx.x >> 6);
    const int G = gridDim.x, bx = blockIdx.x;
    const int vcu = (G % 8 == 0) ? (bx % 8) * (G / 8) + bx / 8 : bx;
    const int gw = vcu * 8 + wave, NGW = G * 8;
    unsigned char* ws = karg_ws();
    unsigned* ctl = (unsigned*)(ws + WS_CTL);
    volatile LAS unsigned* MISC = (volatile LAS unsigned*)(lds + MISC_OFF);
    { const int t = wave * 64 + hw_lane(); if (t < 128) MISC[t] = 0u; }
    __syncthreads();
    volatile LAS int* tp = (volatile LAS int*)(lds + MISC_OFF + 64);
#if MK_PER_PHASE
#define GRID_BAR() do { } while (0)
#else
    XcdBarrier bar = xcd_barrier_post(ctl + CW_BAR + XCD_BAR_WORDS * karg_int(220), MISC, wave == 0 && hw_lane() == 0);
#define GRID_BAR() xcd_barrier(bar, wave == 0 && hw_lane() == 0)
#endif
    const int lo = karg_int(208), hi = karg_int(212);
#define IN(k) (lo <= (k) && (k) < hi)
#define OPAQUE_LANE() int tid_o = wave * 64 + hw_lane(); asm volatile("" : "+v"(tid_o)); const int lane_o = tid_o & 63
#define BOTH(k) (IN(k) && IN((k) + 1))
    bf16* BUFA = (bf16*)(ws + WS_BUFA); bf16* BUFB = (bf16*)(ws + WS_BUFB); bf16* PROJ = (bf16*)(ws + WS_PROJ);
    float* RSTD = (float*)(ws + WS_RSTD);

    if (EN(0) && IN(0)) {
        OPAQUE_LANE(); conv_phase(args, lds, gw, NGW, wave, lane_o);
        if (BOTH(0)) GRID_BAR();
    }
#pragma unroll 1
    for (int l = 0; l < NLAYER; ++l) {
        const int pb = 9 * l;
        unsigned* cnt = ctl + CW_CNT + 64 * l;
        if (EN(1) && IN(pb + 1)) {
            OPAQUE_LANE();
            if (l == 0) { if (G1_I8) norm1_i8_phase<false>(l, nullptr, lds, vcu, G, wave, tid_o); else norm1_phase<false>(args, l, nullptr, lds, vcu, G, wave, tid_o); if (G1_I8) { __syncthreads(); quant_win_phase(lds, gw, NGW, wave, lane_o); } }
            else { if (!(EN(7) && IN(9 * (l - 1) + 7))) build_tp(ctl + CW_CNT + 64 * (l - 1), tp, tid_o);
                   if (G1_I8) norm1_i8_phase<true>(l, (const LAS int*)tp, lds, vcu, G, wave, tid_o); else norm1_phase<true>(args, l, (const LAS int*)tp, lds, vcu, G, wave, tid_o); }
            if (BOTH(pb + 1)) GRID_BAR();
        }
        if (EN(2) && IN(pb + 2)) {
            if (G1_SPLIT) {
                { pg8::DenseOrder S; S.init(BUFA, ws + (l ? WS_WIN1 : WS_WIN), MTOK, 14 * 256, 2048, G, bx, 0);
                  pg8::EpiProjQK<false> E{PROJ, NPROJ, RSTD, 1.0f, karg_in(I_QNG) + l * 64, karg_in(I_KNG) + l * 64, (const f32x4*)(ws + WS_ROPE), (LAS float*)(lds + RING_BYTES), nullptr, nullptr};
                  pg8::gemm_phase<pg8::EpiProjQK<false>, pg8::DenseOrder, true, false>(lds + RING_OFF, S, E, wave); }
                { pg8::DenseOrder S; S.init(ws + WS_A8, ws + WS_WIN8 + (size_t)l * 11 * MiB, MTOK, 8 * 256, 1024, G, bx, 1);
                  pg8::EpiBf16 E{PROJ, NPROJ, RSTD, 1.0f / SC_WIN};
                  pg8::gemm_phase<pg8::EpiBf16, pg8::DenseOrder, true, false, 1>(lds + RING_OFF, S, E, wave); }
            } else if (G1_I8) {
                pg8::DenseOrder S; S.init(ws + WS_A8, ws + WS_WIN8 + (size_t)l * 11 * MiB, MTOK, NPROJ, 1024  , G, bx, 2);
                pg8::EpiProjQK<true> E{PROJ, NPROJ, RSTD, 1.0f, karg_in(I_QNG) + l * 64, karg_in(I_KNG) + l * 64, (const f32x4*)(ws + WS_ROPE), (LAS float*)(lds + RING_BYTES), (const unsigned*)(ws + WS_CTL) + CW_CMAX + 8192 * l, (LAS float*)(lds + RING_BYTES + 8192)};
                pg8::gemm_phase<pg8::EpiProjQK<true>, pg8::DenseOrder, true, false, 2>(lds + RING_OFF, S, E, wave);
            } else {
                pg8::DenseOrder S; S.init(BUFA, ws + (l ? WS_WIN1 : WS_WIN), MTOK, NPROJ, 2048, G, bx);
                pg8::EpiProjQK<false> E{PROJ, NPROJ, RSTD, 1.0f, karg_in(I_QNG) + l * 64, karg_in(I_KNG) + l * 64, (const f32x4*)(ws + WS_ROPE), (LAS float*)(lds + RING_BYTES), nullptr, nullptr};
                pg8::gemm_phase<pg8::EpiProjQK<false>, pg8::DenseOrder, true, false>(lds + RING_OFF, S, E, wave);
            }
            if (BOTH(pb + 2)) GRID_BAR();
        }
        if (EN(4) && IN(pb + 4)) {
            { OPAQUE_LANE();
              if (wave == 0) { const float* lp = karg_in(I_LAM) + l * 256; const float la = lp[lane_o] * lp[64 + lane_o], lb = lp[128 + lane_o] * lp[192 + lane_o];
                  const float lam = __expf(wave_sum(la)) - __expf(wave_sum(lb)) + ((l == 0) ? 0.2f : 0.35550906759096934f);
                  if (lane_o == 0) ((volatile LAS float*)MISC)[6] = lam; }
              __syncthreads(); }
            constexpr int QLEN = 12 + 288 + 128;
            unsigned* qh0 = ctl + CW_Q + 2048 * l + 1024 * karg_int(220);
            const int x0 = (int)(xb_xcc_id() & 7u);
            int kq = 0;
            for (;;) {
                OPAQUE_LANE();
                const int xq = (x0 + kq) & 7;
                if (tid_o == 0) {
                    const unsigned pv = MISC[7];
                    if (pv) { MISC[7] = 0u; MISC[4] = pv - 1u; } else MISC[4] = __hip_atomic_fetch_add(qh0 + 64 * xq, 1u, RLX_AGENT);
                    *(volatile LAS unsigned long long*)(MISC + 8) = (unsigned long long)(qh0 + 64 * xq); }
                __syncthreads();
                const int i = __builtin_amdgcn_readfirstlane((int)MISC[4]);
                __syncthreads();
                if (i >= QLEN) { if (++kq == 8) break; continue; }
                if (i < 12) { if (!(karg_flags() & 16)) mlstm_unit(8 * i + xq, l, args, lds, tid_o, wave, lane_o); }
                else if (i < 300) { const int v = i - 12, g3 = v / 3;
                    if (v % 3 == 2) { if (!(karg_flags() & 128)) conv_moe_unit(8 * g3 + xq, l, lds, wave, lane_o); }
                    else if (!(karg_flags() & 32)) { const int a = v - g3, bh = 8 * (a >> 4) + xq; ATT_UNIT((a & 15) * 96 + bh); } }
                else { if (!(karg_flags() & 64)) gmlp_unit(8 * (i - 300) + xq, l, args, lds, tid_o, wave, lane_o); }
            }
            if (BOTH(pb + 4)) GRID_BAR();
        }
        if (EN(5) && IN(pb + 5)) {
            pg8::DenseOrder S; S.init(BUFB, ws + (l ? WS_WOUT1 : WS_WOUT), MTOK, 2048, 2048, G, bx);
            if (l == 0) { pg8::EpiResBf16<true> E{karg_in(I_X), (bf16*)(ws + WS_XB), 2048}; pg8::gemm_phase<pg8::EpiResBf16<true>, pg8::DenseOrder, true, false>(lds + RING_OFF, S, E, wave); }
            else { pg8::EpiResBf16<false> E{ws + WS_XB, (bf16*)(ws + WS_XB), 2048}; pg8::gemm_phase<pg8::EpiResBf16<false>, pg8::DenseOrder, true, false>(lds + RING_OFF, S, E, wave); }
            if (BOTH(pb + 5)) GRID_BAR();
        }
        if (EN(6) && IN(pb + 6)) {
            OPAQUE_LANE(); norm2_sp_phase(l, lds, vcu, G, wave, tid_o);
            if (BOTH(pb + 6)) GRID_BAR();
        }
        if (EN(7) && IN(pb + 7)) {
            { OPAQUE_LANE(); build_tp(cnt, tp, tid_o); }
            pg8::GroupOrder S; S.A = (const char*)(ws + WS_A8); S.Bt = (const char*)(ws + WS_WGU); S.K = 1024  ; S.NJ = 4; S.bstride_e = (size_t)1024 * 2048;
            S.tp = (const LAS int*)tp; S.list = (const int*)(ws + WS_LIST); S.cnt = cnt; S.G = G; S.c = bx; S.gather = true; S.arow_bytes = 0;
            pg8::EpiSwiglu E{ws + WS_HID, RSTD, S, 1.0f / SC_WGU};
            pg8::gemm_phase<pg8::EpiSwiglu, pg8::GroupOrder, true, true, 1>(lds + RING_OFF, S, E, wave);
            if (BOTH(pb + 7)) GRID_BAR();
        }
        if (EN(8) && IN(pb + 8)) {
            if (!(EN(7) && IN(pb + 7))) { OPAQUE_LANE(); build_tp(cnt, tp, tid_o); }
            pg8::GroupOrder S; S.A = (const char*)(ws + WS_HID); S.Bt = (const char*)(ws + WS_WD); S.K = 256  ; S.NJ = 8; S.bstride_e = (size_t)2048 * 512;
            S.tp = (const LAS int*)tp; S.list = nullptr; S.cnt = cnt; S.G = G; S.c = bx; S.gather = false; S.arow_bytes = (size_t)512;
            pg8::EpiFp8 E{ws + WS_Y, 2048, 1.0f / SC_WD};
            pg8::gemm_phase<pg8::EpiFp8, pg8::GroupOrder, true, false, 1>(lds + RING_OFF, S, E, wave);
            if (BOTH(pb + 8)) GRID_BAR();
        }
    }
    if (EN(9) && IN(9 * NLAYER)) {
        OPAQUE_LANE(); if (!(EN(7) && IN(9 * (NLAYER - 1) + 7))) build_tp(ctl + CW_CNT + 64 * (NLAYER - 1), tp, tid_o);
        final_phase(args, (const LAS int*)tp, gw, NGW, lane_o);
    }
#undef IN
#undef BOTH
}

extern "C" void kernel_launch(void* const* d_in, const int* in_sizes, int n_in, void* d_out, int out_size, void* d_ws, size_t ws_size, hipStream_t stream) {
    static int grid = 0;
    if (grid == 0) {
        if (n_in != 24 || in_sizes[0] != MTOK * DMODEL || out_size != MTOK * DMODEL || ws_size < WS_END) {
            fprintf(stderr, "kernel_launch: unexpected problem (n_in %d, in0 %d, out %d, ws %zu < %zu); nothing launched\n", n_in, n_in > 0 ? in_sizes[0] : -1, out_size, ws_size, (size_t)WS_END); grid = -1; return; }
        int dev = 0, cus = 0, per_cu = 0;
        if (hipGetDevice(&dev) != hipSuccess || hipDeviceGetAttribute(&cus, hipDeviceAttributeMultiprocessorCount, dev) != hipSuccess) { grid = -1; return; }
        if (hipFuncSetAttribute((const void*)hybrid_fwd, hipFuncAttributeMaxDynamicSharedMemorySize, LDS_BYTES) != hipSuccess) { fprintf(stderr, "kernel_launch: hipFuncSetAttribute failed\n"); grid = -1; return; }
        if (hipOccupancyMaxActiveBlocksPerMultiprocessor(&per_cu, (const void*)hybrid_fwd, 512, LDS_BYTES) != hipSuccess || per_cu < 1)
            fprintf(stderr, "kernel_launch: note: occupancy query reports %d workgroups per CU\n", per_cu);
        (void)hipGetLastError();
        grid = cus;
    }
    if (grid < 0) return;
    if (hipMemsetAsync((char*)d_ws + WS_CTL, 0, CTL_ZERO_BYTES, stream) != hipSuccess) return;
    Args a{};
    for (int i = 0; i < 24; ++i) a.in[i] = (const float*)d_in[i];
    a.out = (float*)d_out; a.ws = (unsigned char*)d_ws; a.flags = ABL_FLAGS; a.pad = 0;
#if MK_PER_PHASE
    for (int p = 0; p < NPHASE; ++p) { a.ph_lo = p; a.ph_hi = p + 1; hipLaunchKernelGGL(hybrid_fwd, dim3(grid), dim3(512), LDS_BYTES, stream, a); }
#else
#if PROBE_REP >= 0
    a.ph_lo = 0; a.ph_hi = 9 * PROBE_LAYER + PROBE_REP + 1; a.pad = 0;
    hipLaunchKernelGGL(hybrid_fwd, dim3(grid), dim3(512), LDS_BYTES, stream, a);
    a.ph_lo = 9 * PROBE_LAYER + PROBE_REP; a.ph_hi = a.ph_lo + 1; a.pad = 1; a.flags |= PROBE_SKIP;
#ifdef PROBE_EMPTY
    a.ph_hi = a.ph_lo;
#endif
    hipLaunchKernelGGL(hybrid_fwd, dim3(grid), dim3(512), LDS_BYTES, stream, a);
    a.ph_lo = 9 * PROBE_LAYER + PROBE_REP + 1; a.ph_hi = NPHASE; a.pad = 2; a.flags &= ~PROBE_SKIP;
    hipLaunchKernelGGL(hybrid_fwd, dim3(grid), dim3(512), LDS_BYTES, stream, a);
#else
    a.ph_lo = 0; a.ph_hi = NPHASE;
    hipLaunchKernelGGL(hybrid_fwd, dim3(grid), dim3(512), LDS_BYTES, stream, a);
#endif
#endif
    const hipError_t le = hipPeekAtLastError();
    if (le != hipSuccess) fprintf(stderr, "kernel_launch: launch failed: %s\n", hipGetErrorName(le));
}
```
